# Optimizing an MI355X kernel written in HIP

```python
import math
import jax, jax.numpy as jnp
from jax import lax
import numpy as np

D_MODEL = 1024
BATCH = 8
SEQ = 2048
DEPTH = 1
DEC_BATCH = 128
DEC_SEQ = 1
PAST_LEN = 16384
PAGE_SIZE = 128

RET_HEADS = 4
RET_DK = 128
RET_DV = 256
RET_QK = RET_HEADS * RET_DK
RET_V = RET_HEADS * RET_DV
GDN_HEADS = 8
GDN_DK = 128
GDN_DV = 128
GDN_QK = GDN_HEADS * GDN_DK
GDN_V = GDN_HEADS * GDN_DV
CONV_W = 4
CONV_CH = 2 * GDN_QK + GDN_V
CHUNK = 64
N_MEM = 256
X_HEADS = 4
X_HD = D_MODEL // X_HEADS
D_FF = ((8 * D_MODEL + 3 * 256 - 1) // (3 * 256)) * 256
ROPE_BASE = 10000.0
EPS = 1e-6
IN_SIZES = (RET_QK, RET_QK, RET_V, RET_V, CONV_CH, GDN_V, GDN_HEADS, GDN_HEADS, D_MODEL, D_MODEL)
D_IN = RET_QK * 2 + RET_V * 2 + CONV_CH + GDN_V + 2 * GDN_HEADS + 2 * D_MODEL

kernel_name = 'hybrid_retention_gdn_memxattn_step'


def _offsets(sizes):
    out, acc = [], 0
    for s in sizes[:-1]:
        acc += s
        out.append(acc)
    return out


def rmsnorm(x, g):
    xf = x.astype(jnp.float32)
    return xf * lax.rsqrt(jnp.mean(xf * xf, axis=-1, keepdims=True) + EPS) * g


def l2norm(x):
    return x * lax.rsqrt(jnp.sum(x * x, axis=-1, keepdims=True) + EPS)


def rotary(x, pos):
    half = x.shape[-1] // 2
    inv = ROPE_BASE ** (-jnp.arange(half, dtype=jnp.float32) / half)
    ang = pos.astype(jnp.float32)[:, None] * inv[None, :]
    cos, sin = jnp.cos(ang)[None, :, None, :], jnp.sin(ang)[None, :, None, :]
    x1, x2 = x[..., :half], x[..., half:]
    return jnp.concatenate([x1 * cos - x2 * sin, x1 * sin + x2 * cos], axis=-1)


def chunk_size(t):
    return t if t <= CHUNK else math.gcd(t, CHUNK)


def to_chunks(x, c):
    b, t = x.shape[:2]
    return jnp.moveaxis(x.reshape((b, t // c, c) + x.shape[2:]), 1, 0)


def from_chunks(o):
    n, b, c = o.shape[:3]
    return jnp.moveaxis(o, 0, 1).reshape((b, n * c) + o.shape[3:])


def retention_chunked(q, k, v, s0):
    h = q.shape[2]
    c = chunk_size(q.shape[1])
    log_g = jnp.log1p(-jnp.exp2(-5.0 - jnp.arange(h, dtype=jnp.float32)))
    idx = jnp.arange(c, dtype=jnp.float32)
    diff = idx[:, None] - idx[None, :]
    causal = diff >= 0
    intra_decay = jnp.where(causal[None], jnp.exp(jnp.maximum(diff, 0.0)[None] * log_g[:, None, None]), 0.0)
    q_decay = jnp.exp((idx + 1.0)[:, None] * log_g[None, :])
    k_decay = jnp.exp((c - 1.0 - idx)[:, None] * log_g[None, :])
    chunk_decay = jnp.exp(c * log_g)

    def step(s, xs):
        qc, kc, vc = xs
        scores = jnp.einsum('bihk,bjhk->bhij', qc, kc) * intra_decay
        o = jnp.einsum('bhij,bjhv->bihv', scores, vc) + jnp.einsum('bihk,bhkv->bihv', qc * q_decay[None, :, :, None], s)
        s = chunk_decay[None, :, None, None] * s + jnp.einsum('bjhk,bjhv->bhkv', kc * k_decay[None, :, :, None], vc)
        return s, o

    s, o = lax.scan(step, s0, (to_chunks(q, c), to_chunks(k, c), to_chunks(v, c)))
    return from_chunks(o), s


def gated_delta_chunked(q, k, v, beta, g, s0):
    dv = v.shape[-1]
    c = chunk_size(q.shape[1])
    idx = jnp.arange(c)
    incl = idx[:, None] >= idx[None, :]
    strict = idx[:, None] > idx[None, :]
    eye = jnp.eye(c, dtype=jnp.float32)

    def step(s, xs):
        qc, kc, vc, bc, gc = xs
        gcum = jnp.cumsum(gc, axis=1)
        gh = jnp.transpose(gcum, (0, 2, 1))
        dg = gh[:, :, :, None] - gh[:, :, None, :]
        gamma = jnp.where(incl, jnp.exp(jnp.where(incl, dg, 0.0)), 0.0)
        kk = jnp.einsum('bihk,bjhk->bhij', kc, kc)
        a = jnp.where(strict, kk * gamma * jnp.transpose(bc, (0, 2, 1))[..., None], 0.0)
        rhs = jnp.concatenate([vc * bc[..., None], kc * (bc * jnp.exp(gcum))[..., None]], axis=-1)
        rhs = jnp.transpose(rhs, (0, 2, 1, 3))
        sol = lax.linalg.triangular_solve(a + eye, rhs, left_side=True, lower=True, unit_diagonal=True)
        u, w = sol[..., :dv], sol[..., dv:]
        v_new = u - jnp.einsum('bhik,bhkv->bhiv', w, s)
        qk = jnp.where(incl, jnp.einsum('bihk,bjhk->bhij', qc, kc) * gamma, 0.0)
        qh = jnp.transpose(qc, (0, 2, 1, 3)) * jnp.exp(gh)[..., None]
        o = jnp.einsum('bhik,bhkv->bhiv', qh, s) + jnp.einsum('bhij,bhjv->bhiv', qk, v_new)
        g_last = gh[:, :, -1]
        kh = jnp.transpose(kc, (0, 2, 1, 3)) * jnp.exp(g_last[..., None] - gh)[..., None]
        s = jnp.exp(g_last)[..., None, None] * s + jnp.einsum('bhjk,bhjv->bhkv', kh, v_new)
        return s, jnp.transpose(o, (0, 2, 1, 3))

    xs = (to_chunks(q, c), to_chunks(k, c), to_chunks(v, c), to_chunks(beta, c), to_chunks(g, c))
    s, o = lax.scan(step, s0, xs)
    return from_chunks(o), s


def causal_conv(xc, buf, w):
    t = xc.shape[1]
    full = jnp.concatenate([buf.astype(jnp.float32), xc], axis=1)
    out = full[:, 0:t] * w[0]
    for i in range(1, CONV_W):
        out = out + full[:, i:i + t] * w[i]
    return jax.nn.silu(out), full[:, t:]


def mixer_block(h, s_ret, s_gdn, conv_buf, pos0, w_in, ret_gn_g, w_branch_a, gdn_conv_w, gdn_a_log,
                gdn_dt_bias, gdn_norm_g, w_branch_b, w_out):
    b, t, _ = h.shape
    f32 = jnp.float32
    proj = (h @ w_in).astype(f32)
    rq, rk, rv, rg, qkv, z, bb, aa, ga, gb = jnp.split(proj, _offsets(IN_SIZES), axis=-1)
    pos = pos0 + jnp.arange(t)
    rq = rotary(rq.reshape(b, t, RET_HEADS, RET_DK), pos)
    rk = rotary(rk.reshape(b, t, RET_HEADS, RET_DK), pos) * (RET_DK ** -0.5)
    rv = rv.reshape(b, t, RET_HEADS, RET_DV)
    o_r, s_ret_new = retention_chunked(rq, rk, rv, s_ret.astype(f32))
    mu = jnp.mean(o_r, axis=-1, keepdims=True)
    var = jnp.mean(jnp.square(o_r - mu), axis=-1, keepdims=True)
    o_r = ((o_r - mu) * lax.rsqrt(var + EPS)).reshape(b, t, RET_V) * ret_gn_g
    y_a = (jax.nn.silu(rg) * o_r) @ w_branch_a
    qkv, conv_new = causal_conv(qkv, conv_buf, gdn_conv_w.astype(f32))
    gq, gk, gv = jnp.split(qkv, [GDN_QK, 2 * GDN_QK], axis=-1)
    gq = l2norm(gq.reshape(b, t, GDN_HEADS, GDN_DK)) * (GDN_DK ** -0.5)
    gk = l2norm(gk.reshape(b, t, GDN_HEADS, GDN_DK))
    gv = gv.reshape(b, t, GDN_HEADS, GDN_DV)
    beta = jax.nn.sigmoid(bb)
    g = -jnp.exp(gdn_a_log.astype(f32)) * jax.nn.softplus(aa + gdn_dt_bias)
    o_g, s_gdn_new = gated_delta_chunked(gq, gk, gv, beta, g, s_gdn.astype(f32))
    o_g = rmsnorm(o_g, gdn_norm_g) * jax.nn.silu(z.reshape(b, t, GDN_HEADS, GDN_DV))
    y_b = o_g.reshape(b, t, GDN_V) @ w_branch_b
    merged = jax.nn.sigmoid(ga) * y_a + jax.nn.sigmoid(gb) * y_b
    return merged @ w_out, s_ret_new, s_gdn_new, conv_new


def mem_kv(mem, mem_norm_g, w_xk, w_xv):
    b, m, _ = mem.shape
    mn = rmsnorm(mem, mem_norm_g)
    return (mn @ w_xk).reshape(b, m, X_HEADS, X_HD), (mn @ w_xv).reshape(b, m, X_HEADS, X_HD)


def cross_attn(h, mk, mv, w_xq, w_xo):
    b, t, _ = h.shape
    q = (h @ w_xq).reshape(b, t, X_HEADS, X_HD).astype(jnp.float32)
    s = jnp.einsum('bthd,bmhd->bhtm', q, mk.astype(jnp.float32)) * (X_HD ** -0.5)
    p = jax.nn.softmax(s, axis=-1)
    o = jnp.einsum('bhtm,bmhd->bthd', p, mv.astype(jnp.float32)).reshape(b, t, D_MODEL)
    return o @ w_xo


def swiglu(h, w_gate, w_up, w_down):
    return (jax.nn.silu(h @ w_gate) * (h @ w_up)) @ w_down


def layer(x, s_ret, s_gdn, conv_buf, mk, mv, pos0, norm_mix_g, w_in, ret_gn_g, w_branch_a, gdn_conv_w,
          gdn_a_log, gdn_dt_bias, gdn_norm_g, w_branch_b, w_out, norm_x_g, w_xq, w_xo, norm_ffn_g,
          w_gate, w_up, w_down):
    y, s_ret, s_gdn, conv_buf = mixer_block(rmsnorm(x, norm_mix_g), s_ret, s_gdn, conv_buf, pos0, w_in,
                                            ret_gn_g, w_branch_a, gdn_conv_w, gdn_a_log, gdn_dt_bias,
                                            gdn_norm_g, w_branch_b, w_out)
    x = x + y
    x = x + cross_attn(rmsnorm(x, norm_x_g), mk, mv, w_xq, w_xo)
    x = x + swiglu(rmsnorm(x, norm_ffn_g), w_gate, w_up, w_down)
    return x, s_ret, s_gdn, conv_buf


def setup_inputs(seed: int = 0) -> dict:
    key = jax.random.key(seed)
    ks = jax.random.split(key, 40)
    f32 = jnp.float32
    L = DEPTH

    def nrm(k, shape, scale):
        return jax.random.normal(k, shape, f32) * scale

    def gain(k, shape):
        return 1.0 + 0.01 * jax.random.normal(k, shape, f32)

    dt = jnp.exp(jax.random.uniform(ks[0], (L, GDN_HEADS), f32, math.log(1e-3), math.log(1e-1)))
    dt_bias = dt + jnp.log(-jnp.expm1(-dt))
    a_log = jnp.log(jax.random.uniform(ks[1], (L, GDN_HEADS), f32, 1.0, 16.0))
    return {
        'x_prompt': nrm(ks[2], (BATCH, SEQ, D_MODEL), 1.0),
        'x_sample': nrm(ks[3], (DEC_BATCH, DEC_SEQ, D_MODEL), 1.0),
        'state_ret': nrm(ks[4], (L, DEC_BATCH, RET_HEADS, RET_DK, RET_DV), 0.1),
        'state_gdn': nrm(ks[5], (L, DEC_BATCH, GDN_HEADS, GDN_DK, GDN_DV), 0.1),
        'state_conv': nrm(ks[6], (L, DEC_BATCH, CONV_W - 1, CONV_CH), 1.0),
        'cache_mem_k': nrm(ks[7], (L, DEC_BATCH, N_MEM, X_HEADS, X_HD), 1.0),
        'cache_mem_v': nrm(ks[8], (L, DEC_BATCH, N_MEM, X_HEADS, X_HD), 1.0),
        'mem_prompt': nrm(ks[9], (BATCH, N_MEM, D_MODEL), 1.0),
        'norm_mix_g': gain(ks[10], (L, D_MODEL)),
        'w_in': nrm(ks[11], (L, D_MODEL, D_IN), D_MODEL ** -0.5),
        'ret_gn_g': gain(ks[12], (L, RET_V)),
        'w_branch_a': nrm(ks[13], (L, RET_V, D_MODEL), RET_V ** -0.5),
        'gdn_conv_w': nrm(ks[14], (L, CONV_W, CONV_CH), CONV_W ** -0.5),
        'gdn_a_log': a_log,
        'gdn_dt_bias': dt_bias,
        'gdn_norm_g': gain(ks[15], (L, GDN_DV)),
        'w_branch_b': nrm(ks[16], (L, GDN_V, D_MODEL), GDN_V ** -0.5),
        'w_out': nrm(ks[17], (L, D_MODEL, D_MODEL), D_MODEL ** -0.5),
        'norm_x_g': gain(ks[18], (L, D_MODEL)),
        'mem_norm_g': gain(ks[19], (L, D_MODEL)),
        'w_xq': nrm(ks[20], (L, D_MODEL, D_MODEL), D_MODEL ** -0.5),
        'w_xk': nrm(ks[21], (L, D_MODEL, D_MODEL), D_MODEL ** -0.5),
        'w_xv': nrm(ks[22], (L, D_MODEL, D_MODEL), D_MODEL ** -0.5),
        'w_xo': nrm(ks[23], (L, D_MODEL, D_MODEL), D_MODEL ** -0.5),
        'norm_ffn_g': gain(ks[24], (L, D_MODEL)),
        'w_gate': nrm(ks[25], (L, D_MODEL, D_FF), D_MODEL ** -0.5),
        'w_up': nrm(ks[26], (L, D_MODEL, D_FF), D_MODEL ** -0.5),
        'w_down': nrm(ks[27], (L, D_FF, D_MODEL), D_FF ** -0.5),
        'norm_final_g': gain(ks[28], (D_MODEL,)),
    }


def reference(x_prompt, x_sample, state_ret, state_gdn, state_conv, cache_mem_k, cache_mem_v, mem_prompt,
              norm_mix_g, w_in, ret_gn_g, w_branch_a, gdn_conv_w, gdn_a_log, gdn_dt_bias, gdn_norm_g,
              w_branch_b, w_out, norm_x_g, mem_norm_g, w_xq, w_xk, w_xv, w_xo, norm_ffn_g, w_gate, w_up,
              w_down, norm_final_g):
    f32 = jnp.float32
    bp = x_prompt.shape[0]
    xp, xs = x_prompt, x_sample
    sr_p_l, sg_p_l, sc_p_l, mk_p_l, mv_p_l, sr_s_l, sg_s_l, sc_s_l = [], [], [], [], [], [], [], []
    for l in range(DEPTH):
        lw = (norm_mix_g[l], w_in[l], ret_gn_g[l], w_branch_a[l], gdn_conv_w[l], gdn_a_log[l], gdn_dt_bias[l],
              gdn_norm_g[l], w_branch_b[l], w_out[l], norm_x_g[l], w_xq[l], w_xo[l], norm_ffn_g[l], w_gate[l],
              w_up[l], w_down[l])
        mk_p, mv_p = mem_kv(mem_prompt, mem_norm_g[l], w_xk[l], w_xv[l])
        xp, sr_p, sg_p, sc_p = layer(xp, jnp.zeros((bp, RET_HEADS, RET_DK, RET_DV), f32),
                                     jnp.zeros((bp, GDN_HEADS, GDN_DK, GDN_DV), f32),
                                     jnp.zeros((bp, CONV_W - 1, CONV_CH), f32), mk_p, mv_p, 0, *lw)
        xs, sr_s, sg_s, sc_s = layer(xs, state_ret[l], state_gdn[l], state_conv[l], cache_mem_k[l],
                                     cache_mem_v[l], PAST_LEN, *lw)
        sr_p_l.append(sr_p); sg_p_l.append(sg_p); sc_p_l.append(sc_p)
        mk_p_l.append(mk_p); mv_p_l.append(mv_p)
        sr_s_l.append(sr_s); sg_s_l.append(sg_s); sc_s_l.append(sc_s)
    y_prompt = rmsnorm(xp, norm_final_g)
    y_sample = rmsnorm(xs, norm_final_g)
    return (y_prompt, y_sample, jnp.stack(sr_p_l), jnp.stack(sg_p_l), jnp.stack(sc_p_l), jnp.stack(mk_p_l),
            jnp.stack(mv_p_l), jnp.stack(sr_s_l), jnp.stack(sg_s_l), jnp.stack(sc_s_l))
```

```cpp
#include <hip/hip_runtime.h>
#include <hip/hip_cooperative_groups.h>
#include <stdint.h>
#include <math.h>
#include <cstdio>
namespace cg = cooperative_groups;

typedef unsigned short bf16_t;
using bf16x8 = __attribute__((ext_vector_type(8))) short;
using f32x4 = __attribute__((ext_vector_type(4))) float;

#define NTOK 16512
#define NPR 16384
#define EPSF 1e-6f
#define NPHASE 13
#define SMEM_BYTES 73728

struct ConvJob {
  const float* src0; const float* src1; const float* gfold; bf16_t* dst;
  int ld_src; int K; int Nd; int mode; float scale; int tile0;
};

struct Params {
  const float *x_prompt, *x_sample, *state_ret, *state_gdn, *state_conv, *cache_k, *cache_v, *mem_prompt;
  const float *norm_mix_g, *w_in, *ret_gn_g, *w_a, *conv_w, *a_log, *dt_bias, *gdn_norm_g, *w_b, *w_out;
  const float *norm_x_g, *mem_norm_g, *w_xq, *w_xk, *w_xv, *w_xo, *norm_ffn_g, *w_gate, *w_up, *w_down, *norm_final_g;
  float* out;
  bf16_t *Wt_in, *Wt_a, *Wt_b, *Wt_out, *Wt_xq, *Wt_kv, *Wt_xo, *Wt_gu, *Wt_down;
  bf16_t *h, *mn; float *ropec, *ropes;
  bf16_t *P_rqk, *P_rv, *P_rg, *P_qkv, *P_z, *P_ga, *P_gb;
  float *beta, *gl;
  bf16_t *mkb, *mvT;
  bf16_t *g_W, *g_QH, *g_KT, *g_QK, *g_U; float* g_GS;
  bf16_t *r_QD, *r_KDT, *r_SC;
  bf16_t *o_r, *o_g, *ya, *yb, *merged, *x1b, *q, *ao, *x2b, *ff;
  float *ss1, *ss2, *ss3;
  unsigned* bar;
  float* skacc; unsigned* sktick;
  ConvJob jobs[9];
  int n_wtiles; int pad0;
};

__device__ const double c_inv_rev[64] = {
  0.15915494309189535, 0.13782250260398285, 0.11934937021124886, 0.10335229661843406,
  0.08949940160889101, 0.07750328875537406, 0.06711508300522726, 0.058119267441876246,
  0.050329212104487035, 0.04358330210530733, 0.03774158471741977, 0.032682865872357,
  0.0283021958306234, 0.024508691862069852, 0.02122365276477766, 0.018378926105679667,
  0.015915494309189534, 0.013782250260398284, 0.011934937021124886, 0.010335229661843406,
  0.008949940160889102, 0.0077503288755374055, 0.006711508300522725, 0.005811926744187624,
  0.005032921210448704, 0.004358330210530733, 0.003774158471741977, 0.0032682865872356993,
  0.00283021958306234, 0.002450869186206985, 0.0021223652764777662, 0.0018378926105679667,
  0.0015915494309189536, 0.0013782250260398288, 0.0011934937021124885, 0.0010335229661843405,
  0.0008949940160889102, 0.0007750328875537405, 0.0006711508300522726, 0.0005811926744187624,
  0.0005032921210448703, 0.0004358330210530733, 0.00037741584717419774, 0.0003268286587235699,
  0.00028302195830623395, 0.00024508691862069854, 0.0002122365276477766, 0.00018378926105679666,
  0.00015915494309189535, 0.00013782250260398286, 0.00011934937021124886, 0.00010335229661843406,
  8.949940160889102e-05, 7.750328875537406e-05, 6.711508300522725e-05, 5.811926744187624e-05,
  5.0329212104487035e-05, 4.358330210530732e-05, 3.774158471741978e-05, 3.2682865872357e-05,
  2.8302195830623396e-05, 2.4508691862069852e-05, 2.122365276477766e-05, 1.8378926105679668e-05,
};

#define OUT_Y 0
#define OUT_SR_P 16908288
#define OUT_SG_P 17956864
#define OUT_SC_P 19005440
#define OUT_MK_P 19079168
#define OUT_MV_P 21176320
#define OUT_SR_S 23273472
#define OUT_SG_S 40050688
#define OUT_SC_S 56827904

__device__ __forceinline__ unsigned short f2bf(float f) {
  unsigned u = __float_as_uint(f);
  u += 0x7fffu + ((u >> 16) & 1u);
  return (unsigned short)(u >> 16);
}
__device__ __forceinline__ float bf2f(unsigned short b) { return __uint_as_float(((unsigned)b) << 16); }
__device__ __forceinline__ unsigned pack2(float a, float b) { return (unsigned)f2bf(a) | ((unsigned)f2bf(b) << 16); }
__device__ __forceinline__ uint2 pack4(float a, float b, float c, float d) { return make_uint2(pack2(a, b), pack2(c, d)); }
__device__ __forceinline__ uint4 pack8(const float* v) {
  return make_uint4(pack2(v[0], v[1]), pack2(v[2], v[3]), pack2(v[4], v[5]), pack2(v[6], v[7]));
}
__device__ __forceinline__ void unpack8(uint4 r, float* v) {
  v[0] = __uint_as_float(r.x << 16); v[1] = __uint_as_float(r.x & 0xffff0000u);
  v[2] = __uint_as_float(r.y << 16); v[3] = __uint_as_float(r.y & 0xffff0000u);
  v[4] = __uint_as_float(r.z << 16); v[5] = __uint_as_float(r.z & 0xffff0000u);
  v[6] = __uint_as_float(r.w << 16); v[7] = __uint_as_float(r.w & 0xffff0000u);
}
__device__ __forceinline__ void unpack4(uint2 r, float* v) {
  v[0] = __uint_as_float(r.x << 16); v[1] = __uint_as_float(r.x & 0xffff0000u);
  v[2] = __uint_as_float(r.y << 16); v[3] = __uint_as_float(r.y & 0xffff0000u);
}
__device__ __forceinline__ f32x4 mfma16(bf16x8 a, bf16x8 b, f32x4 c) {
  return __builtin_amdgcn_mfma_f32_16x16x32_bf16(a, b, c, 0, 0, 0);
}
__device__ __forceinline__ bf16x8 ldfrag(const bf16_t* p) { return *reinterpret_cast<const bf16x8*>(p); }
__device__ __forceinline__ float4 ldnt4(const float* p) {
  const f32x4 v = __builtin_nontemporal_load(reinterpret_cast<const f32x4*>(p));
  return make_float4(v[0], v[1], v[2], v[3]);
}
__device__ __forceinline__ void stnt4(float* p, float4 v) {
  f32x4 t = {v.x, v.y, v.z, v.w};
  __builtin_nontemporal_store(t, reinterpret_cast<f32x4*>(p));
}
__device__ __forceinline__ float sigmoidf_(float x) { return 1.f / (1.f + __expf(-x)); }
__device__ __forceinline__ float siluf_(float x) { return x / (1.f + __expf(-x)); }
__device__ __forceinline__ float wave_sum(float v) {
  for (int o = 32; o > 0; o >>= 1) v += __shfl_xor(v, o);
  return v;
}

#define LROW 72
__device__ __forceinline__ void gemm_acc(f32x4 (&acc)[4][4], const bf16_t* __restrict__ A, int lda,
                                         const bf16_t* __restrict__ Bt, int ldb, int K, bf16_t* sm,
                                         bool pre = false, const bf16_t* nA = nullptr, int nlda = 0,
                                         const bf16_t* nB = nullptr, int nldb = 0) {
  const int tid = threadIdx.x, lane = tid & 63, wid = tid >> 6;
  const int wr = wid >> 1, wc = wid & 1, fr = lane & 15, fq = lane >> 4;
  unsigned char* smb = (unsigned char*)sm;
  const int nk = K >> 6;
  const int drow = lane >> 3, dpos = lane & 7;
  const bf16_t* Asrc[4]; const bf16_t* Bsrc[4];
#pragma unroll
  for (int j = 0; j < 4; ++j) {
    const int r = (wid * 4 + j) * 8 + drow;
    const int c = dpos ^ ((r >> 1) & 7);
    Asrc[j] = A + (size_t)r * lda + c * 8;
    Bsrc[j] = Bt + (size_t)r * ldb + c * 8;
  }
  const unsigned lds_base = (unsigned)(size_t)(__attribute__((address_space(3))) unsigned char*)smb;
  const unsigned lds_w = __builtin_amdgcn_readfirstlane(lds_base + wid * 4096);
#define GLDS16(gsrc, ldsaddr) do { unsigned _keep; const unsigned _la = (ldsaddr);                                      \
    asm volatile("s_mov_b32 %0, m0\n\ts_mov_b32 m0, %2\n\ts_nop 0\n\tglobal_load_lds_dwordx4 %1, off\n\ts_mov_b32 m0, %0" \
                 : "=&s"(_keep) : "v"(gsrc), "s"(_la) : "memory"); } while (0)
#define GEMM_ISSUE(stage, k0)                                                                                           \
  _Pragma("unroll") for (int j = 0; j < 4; ++j) {                                                                      \
    GLDS16(Asrc[j] + (k0), lds_w + (stage) * 32768 + j * 1024);                                                        \
    GLDS16(Bsrc[j] + (k0), lds_w + (stage) * 32768 + 16384 + j * 1024);                                                \
  }
  if (!pre) {
    asm volatile("s_waitcnt vmcnt(0)" ::: "memory");
    GEMM_ISSUE(0, 0)
  }
  const int rdA = (wr * 64 + fr) * 128, rdB = 16384 + (wc * 64 + fr) * 128;
  const int sw = fr >> 1;
  for (int kt = 0; kt < nk; ++kt) {
    const int cur = kt & 1;
    asm volatile("s_waitcnt vmcnt(0)" ::: "memory");
    asm volatile("s_waitcnt lgkmcnt(0)" ::: "memory");
    __builtin_amdgcn_s_barrier();
    if (kt + 1 < nk) {
      if (cur) { GEMM_ISSUE(0, (kt + 1) * 64) } else { GEMM_ISSUE(1, (kt + 1) * 64) }
    } else if (nA != nullptr) {
#pragma unroll
      for (int j = 0; j < 4; ++j) {
        const int r = (wid * 4 + j) * 8 + drow;
        const int c = dpos ^ ((r >> 1) & 7);
        GLDS16(nA + (size_t)r * nlda + c * 8, lds_w + j * 1024);
        GLDS16(nB + (size_t)r * nldb + c * 8, lds_w + 16384 + j * 1024);
      }
    }
    const unsigned char* cA = smb + cur * 32768 + rdA;
    const unsigned char* cB = smb + cur * 32768 + rdB;
#pragma unroll
    for (int kk = 0; kk < 2; ++kk) {
      bf16x8 af[4], bfr[4];
      const int co = ((kk * 4 + fq) ^ sw) * 16;
#pragma unroll
      for (int i = 0; i < 4; ++i) {
        af[i] = *reinterpret_cast<const bf16x8*>(cA + i * 2048 + co);
        bfr[i] = *reinterpret_cast<const bf16x8*>(cB + i * 2048 + co);
      }
      __builtin_amdgcn_s_setprio(1);
#pragma unroll
      for (int ci = 0; ci < 4; ++ci)
#pragma unroll
        for (int ri = 0; ri < 4; ++ri) acc[ci][ri] = mfma16(bfr[ci], af[ri], acc[ci][ri]);
      __builtin_amdgcn_s_setprio(0);
    }
  }
  __syncthreads();
#undef GEMM_ISSUE
#undef GLDS16
}

__device__ __forceinline__ int first_item(int lo) {
  const int G = gridDim.x;
  int r = ((int)blockIdx.x - lo) % G; if (r < 0) r += G;
  return lo + r;
}
__device__ __forceinline__ void tile_range(int T, int& t0, int& t1, int& step) {
  const int G = gridDim.x;
  if (G & 7) { t0 = blockIdx.x; t1 = T; step = G; return; }
  const int x = blockIdx.x & 7, l = blockIdx.x >> 3;
  t0 = (int)(((long)x * T) >> 3) + l; t1 = (int)(((long)(x + 1) * T) >> 3); step = G >> 3;
}
__device__ __forceinline__ void tile_decode(int t, int MT, int NT, int& mt, int& nt) {
  const int ng = NT >> 3, gs = MT * 8;
  if (t < ng * gs) { const int g = t / gs, r = t - g * gs; mt = r >> 3; nt = g * 8 + (r & 7); }
  else { const int rem = NT & 7; const int r = t - ng * gs; mt = r / rem; nt = ng * 8 + r % rem; }
}
#define ZERO_ACC(acc) _Pragma("unroll") for (int _a = 0; _a < 4; ++_a) _Pragma("unroll") for (int _b = 0; _b < 4; ++_b) acc[_a][_b] = f32x4{0.f, 0.f, 0.f, 0.f};

__device__ __forceinline__ void phase0(const Params& p, unsigned char* smraw) {
  const int tid = threadIdx.x, lane = tid & 63, wid = tid >> 6;
  const int G = gridDim.x;
  for (int it = first_item(0); it < p.n_wtiles; it += G) {
    struct { const float* src0; const float* src1; const float* gfold; bf16_t* dst; int ld_src, K, Nd, mode; float scale; int tile0; } jb;
#define JSEL(F) jb.F = p.jobs[0].F; _Pragma("unroll") for (int q = 1; q < 9; ++q) if (it >= p.jobs[q].tile0) jb.F = p.jobs[q].F;
    JSEL(src0) JSEL(src1) JSEL(gfold) JSEL(dst) JSEL(ld_src) JSEL(K) JSEL(Nd) JSEL(mode) JSEL(scale) JSEL(tile0)
#undef JSEL
    const int tl = it - jb.tile0;
    const int nRt = jb.Nd >> 6;
    const int R = (tl % nRt) * 64 + lane, k0 = (tl / nRt) * 256 + wid * 64;
    const float* src = jb.src0; int col = R; bool valid = true;
    if (jb.mode == 1) {
      if (R < 7168) col = R; else if (R < 9216) col = R + 16; else if (R < 9232) col = 7168 + (R - 9216); else valid = false;
    } else if (jb.mode == 2) {
      col = R >> 1; if (R & 1) src = jb.src1;
    } else if (jb.mode == 3) {
      if (R >= 1024) { src = jb.src1; col = R - 1024; }
    }
    const float* sp = src + (size_t)k0 * jb.ld_src + col;
    bf16_t* dp = jb.dst + (size_t)R * jb.K + k0;
    const float* gf = jb.gfold;
    const float scale = jb.scale;
#pragma unroll 2
    for (int kb = 0; kb < 64; kb += 32) {
      float v[32];
#pragma unroll
      for (int i = 0; i < 32; ++i) v[i] = valid ? __builtin_nontemporal_load(sp + (size_t)(kb + i) * jb.ld_src) : 0.f;
#pragma unroll
      for (int i = 0; i < 32; ++i) { v[i] *= scale; if (gf) v[i] *= gf[k0 + kb + i]; }
#pragma unroll
      for (int i = 0; i < 32; i += 8) *reinterpret_cast<uint4*>(dp + kb + i) = pack8(v + i);
    }
  }
  const int n_rowitems = (NTOK + 2048) / 8;
  for (int it = first_item(p.n_wtiles); it < p.n_wtiles + n_rowitems; it += G) {
    const int rbase = (it - p.n_wtiles) * 8 + wid * 2;
    const float* src[2]; bf16_t* dst[2];
#pragma unroll
    for (int q = 0; q < 2; ++q) {
      const int r = rbase + q;
      if (r < NPR) { src[q] = p.x_prompt + (size_t)r * 1024; dst[q] = p.h + (size_t)r * 1024; }
      else if (r < NTOK) { src[q] = p.x_sample + (size_t)(r - NPR) * 1024; dst[q] = p.h + (size_t)r * 1024; }
      else { src[q] = p.mem_prompt + (size_t)(r - NTOK) * 1024; dst[q] = p.mn + (size_t)(r - NTOK) * 1024; }
    }
    float4 v[2][4];
#pragma unroll
    for (int q = 0; q < 2; ++q)
#pragma unroll
      for (int i = 0; i < 4; ++i) v[q][i] = ldnt4(src[q] + i * 256 + lane * 4);
#pragma unroll
    for (int q = 0; q < 2; ++q) {
      float ss = 0.f;
#pragma unroll
      for (int i = 0; i < 4; ++i) ss += v[q][i].x * v[q][i].x + v[q][i].y * v[q][i].y + v[q][i].z * v[q][i].z + v[q][i].w * v[q][i].w;
      ss = wave_sum(ss);
      const float rs = rsqrtf(ss * (1.f / 1024.f) + EPSF);
#pragma unroll
      for (int i = 0; i < 4; ++i)
        *reinterpret_cast<uint2*>(dst[q] + i * 256 + lane * 4) = pack4(v[q][i].x * rs, v[q][i].y * rs, v[q][i].z * rs, v[q][i].w * rs);
    }
  }
  const int n_rope = (2049 * 64 + 255) / 256;
  for (int it = first_item(p.n_wtiles + n_rowitems); it < p.n_wtiles + n_rowitems + n_rope; it += G) {
    const int e = (it - p.n_wtiles - n_rowitems) * 256 + tid;
    if (e < 2049 * 64) {
      const int pr = e >> 6, i = e & 63;
      const double pos = (pr == 2048) ? 16384.0 : (double)pr;
      double rev = pos * c_inv_rev[i];
      rev = rev - floor(rev);
      const float fr_ = (float)rev;
      p.ropec[e] = __builtin_amdgcn_cosf(fr_);
      p.ropes[e] = __builtin_amdgcn_sinf(fr_);
    }
  }
  for (int i = blockIdx.x * 256 + tid; i < 92 * 16384 / 4; i += G * 256)
    reinterpret_cast<float4*>(p.skacc)[i] = make_float4(0.f, 0.f, 0.f, 0.f);
  if (blockIdx.x == 0 && tid < 128) p.sktick[tid] = 0u;
}

__device__ __forceinline__ void phase1(const Params& p, unsigned char* smraw) {
  const int tid = threadIdx.x, lane = tid & 63, wid = tid >> 6;
  const int wr = wid >> 1, wc = wid & 1, fr = lane & 15, fq = lane >> 4;
  bf16_t* sm = (bf16_t*)smraw;
  const int nMain = 129 * 72;
  const int total = nMain + 129 + 256;
  int t0, t1, tstep;
  tile_range(nMain, t0, t1, tstep);
  auto tile_ops = [&](int t, const bf16_t*& A, const bf16_t*& B) __attribute__((always_inline)) {
    if (t < nMain + 129) {
      int mt, nt;
      if (t < nMain) tile_decode(t, 129, 72, mt, nt); else { mt = t - nMain; nt = 72; }
      A = p.h + (size_t)mt * 128 * 1024; B = p.Wt_in + (size_t)nt * 128 * 1024;
    } else {
      const int t2 = t - nMain - 129;
      A = p.mn + (size_t)(t2 >> 4) * 128 * 1024; B = p.Wt_kv + (size_t)(t2 & 15) * 128 * 1024;
    }
  };
  bool pre = false;
  for (int t = t0;; t += tstep) {
    if (t >= t1) {
      if (t1 < nMain + 1) { t = nMain + blockIdx.x; t1 = total; tstep = gridDim.x; }
      if (t >= t1) break;
    }
    int tn = t + tstep;
    if (tn >= t1) { if (t1 < nMain + 1) { tn = nMain + blockIdx.x; if (tn >= total) tn = -1; } else tn = -1; }
    const bf16_t *nA = nullptr, *nB = nullptr;
    if (tn >= 0) tile_ops(tn, nA, nB);
    f32x4 acc[4][4];
    ZERO_ACC(acc);
    if (t < nMain + 129) {
      int mt, nt;
      if (t < nMain) tile_decode(t, 129, 72, mt, nt); else { mt = t - nMain; nt = 72; }
      gemm_acc(acc, p.h + (size_t)mt * 128 * 1024, 1024, p.Wt_in + (size_t)nt * 128 * 1024, 1024, 1024, sm, pre, nA, 1024, nB, 1024);
      pre = (tn >= 0);
      const int row0 = mt * 128 + wr * 64 + fr;
      if (nt < 72) {
        bf16_t* dst; int ldc, cb;
        if (nt < 8) { dst = p.P_rqk; ldc = 1024; cb = nt * 128; }
        else if (nt < 16) { dst = p.P_rv; ldc = 1024; cb = (nt - 8) * 128; }
        else if (nt < 24) { dst = p.P_rg; ldc = 1024; cb = (nt - 16) * 128; }
        else if (nt < 48) { dst = p.P_qkv; ldc = 3072; cb = (nt - 24) * 128; }
        else if (nt < 56) { dst = p.P_z; ldc = 1024; cb = (nt - 48) * 128; }
        else if (nt < 64) { dst = p.P_ga; ldc = 1024; cb = (nt - 56) * 128; }
        else { dst = p.P_gb; ldc = 1024; cb = (nt - 64) * 128; }
#pragma unroll
        for (int ci = 0; ci < 4; ++ci)
#pragma unroll
          for (int ri = 0; ri < 4; ++ri) {
            const int row = row0 + ri * 16, col = cb + wc * 64 + ci * 16 + fq * 4;
            *reinterpret_cast<uint2*>(dst + (size_t)row * ldc + col) = pack4(acc[ci][ri][0], acc[ci][ri][1], acc[ci][ri][2], acc[ci][ri][3]);
          }
      } else if (wc == 0) {
#pragma unroll
        for (int ri = 0; ri < 4; ++ri) {
          const int row = row0 + ri * 16;
#pragma unroll
          for (int j = 0; j < 4; ++j) {
            const int c = fq * 4 + j;
            const float v = acc[0][ri][j];
            if (c < 8) p.beta[(size_t)row * 8 + c] = sigmoidf_(v);
            else {
              const int hh = c - 8;
              const float xx = v + p.dt_bias[hh];
              const float sp = fmaxf(xx, 0.f) + log1pf(__expf(-fabsf(xx)));
              p.gl[(size_t)row * 8 + hh] = -__expf(p.a_log[hh]) * sp;
            }
          }
        }
      }
    } else {
      const int t2 = t - nMain - 129;
      const int mt = t2 >> 4, nt = t2 & 15;
      gemm_acc(acc, p.mn + (size_t)mt * 128 * 1024, 1024, p.Wt_kv + (size_t)nt * 128 * 1024, 1024, 1024, sm, pre, nA, 1024, nB, 1024);
      pre = (tn >= 0);
      const int row0 = mt * 128 + wr * 64 + fr;
#pragma unroll
      for (int ci = 0; ci < 4; ++ci)
#pragma unroll
        for (int ri = 0; ri < 4; ++ri) {
          const int row = row0 + ri * 16, col = nt * 128 + wc * 64 + ci * 16 + fq * 4;
          const float4 v = make_float4(acc[ci][ri][0], acc[ci][ri][1], acc[ci][ri][2], acc[ci][ri][3]);
          if (col < 1024) {
            *reinterpret_cast<float4*>(p.out + OUT_MK_P + (size_t)row * 1024 + col) = v;
            *reinterpret_cast<uint2*>(p.mkb + (size_t)row * 1024 + col) = pack4(v.x, v.y, v.z, v.w);
          } else {
            const int c2 = col - 1024;
            *reinterpret_cast<float4*>(p.out + OUT_MV_P + (size_t)row * 1024 + c2) = v;
            const int b = row >> 8, key = row & 255, hh = c2 >> 8, d = c2 & 255;
            bf16_t* o = p.mvT + ((size_t)(b * 4 + hh) * 256 + d) * 256 + key;
            o[0] = f2bf(v.x); o[256] = f2bf(v.y); o[512] = f2bf(v.z); o[768] = f2bf(v.w);
          }
        }
    }
  }
}

__device__ __forceinline__ void gdn_pre(const Params& p, int item, unsigned char* smraw) {
  int tid_ = threadIdx.x;
  asm volatile("" : "+v"(tid_));
  const int tid = tid_, lane = tid & 63, w = tid >> 6;
  const int fr = lane & 15, fq = lane >> 4;
  const int h = item & 7, n = (item >> 3) & 31, b = item >> 8;
  const int pit = (b * 8 + h) * 32 + n;
  bf16_t* q_s = (bf16_t*)smraw;
  float* A_s = (float*)smraw;
  bf16_t* k_s = q_s + 64 * 136;
  bf16_t* kT = k_s + 64 * 136;
  bf16_t* vT = kT + 128 * 72;
  float* gc = (float*)(vT + 128 * 72);
  float* bt = gc + 64;
  float* eg = bt + 64;
  const size_t row0 = (size_t)b * 2048 + n * 64;
  if (tid < 64) {
    float g = p.gl[(row0 + tid) * 8 + h];
    for (int off = 1; off < 64; off <<= 1) { float t = __shfl_up(g, off); if (lane >= off) g += t; }
    gc[tid] = g; bt[tid] = p.beta[(row0 + tid) * 8 + h]; eg[tid] = __expf(g);
  }
  __syncthreads();
  const float glast = gc[63];
  {
    const int cc = tid & 15, rg4 = (tid >> 4) * 4;
#pragma unroll 1
    for (int mat = 0; mat < 3; ++mat) {
      const int chb = mat * 1024 + h * 128 + cc * 8;
      uint4 raw[7];
#pragma unroll
      for (int d = 0; d < 7; ++d) {
        const int t = n * 64 + rg4 - 3 + d;
        const int tcl = t < 0 ? 0 : t;
        raw[d] = *reinterpret_cast<const uint4*>(p.P_qkv + ((size_t)b * 2048 + tcl) * 3072 + chb);
      }
      float wv[4][8];
#pragma unroll
      for (int tap = 0; tap < 4; ++tap) {
        const float4 a = *reinterpret_cast<const float4*>(p.conv_w + tap * 3072 + chb);
        const float4 c = *reinterpret_cast<const float4*>(p.conv_w + tap * 3072 + chb + 4);
        wv[tap][0] = a.x; wv[tap][1] = a.y; wv[tap][2] = a.z; wv[tap][3] = a.w;
        wv[tap][4] = c.x; wv[tap][5] = c.y; wv[tap][6] = c.z; wv[tap][7] = c.w;
      }
#pragma unroll
      for (int d = 0; d < 7; ++d)
        if (n * 64 + rg4 - 3 + d < 0) raw[d] = make_uint4(0u, 0u, 0u, 0u);
#pragma unroll
      for (int i = 0; i < 4; ++i) {
        const int r = rg4 + i;
        float a8[8];
#pragma unroll
        for (int e = 0; e < 8; ++e) a8[e] = 0.f;
#pragma unroll
        for (int tap = 0; tap < 4; ++tap) {
          float xt[8]; unpack8(raw[i + tap], xt);
#pragma unroll
          for (int e = 0; e < 8; ++e) a8[e] += wv[tap][e] * xt[e];
        }
#pragma unroll
        for (int e = 0; e < 8; ++e) a8[e] = siluf_(a8[e]);
        if (mat < 2) {
          float ss = 0.f;
#pragma unroll
          for (int e = 0; e < 8; ++e) ss += a8[e] * a8[e];
          ss += __shfl_xor(ss, 1); ss += __shfl_xor(ss, 2); ss += __shfl_xor(ss, 4); ss += __shfl_xor(ss, 8);
          float sc = rsqrtf(ss + EPSF);
          if (mat == 0) sc *= 0.08838834764831845f;
#pragma unroll
          for (int e = 0; e < 8; ++e) a8[e] *= sc;
        }
        if (mat == 0) {
          *reinterpret_cast<uint4*>(q_s + r * 136 + cc * 8) = pack8(a8);
          const float egr = eg[r];
          float qh[8];
#pragma unroll
          for (int e = 0; e < 8; ++e) qh[e] = a8[e] * egr;
          *reinterpret_cast<uint4*>(p.g_QH + (size_t)pit * 8192 + r * 128 + cc * 8) = pack8(qh);
        } else if (mat == 1) {
          *reinterpret_cast<uint4*>(k_s + r * 136 + cc * 8) = pack8(a8);
#pragma unroll
          for (int e = 0; e < 8; ++e) kT[(cc * 8 + e) * 72 + r] = f2bf(a8[e]);
        } else {
#pragma unroll
          for (int e = 0; e < 8; ++e) vT[(cc * 8 + e) * 72 + r] = f2bf(a8[e]);
        }
        asm volatile("" ::: "memory");
      }
    }
  }
  if (n == 31 && tid < 144) {
    const int i = tid / 48, ch = tid % 48, mat = ch >> 4, c16 = ch & 15;
    const int col = mat * 1024 + h * 128 + c16 * 8;
    const uint4 raw = *reinterpret_cast<const uint4*>(p.P_qkv + ((size_t)b * 2048 + 2045 + i) * 3072 + col);
    float x[8]; unpack8(raw, x);
    float* o = p.out + OUT_SC_P + ((size_t)b * 3 + i) * 3072 + col;
    *reinterpret_cast<float4*>(o) = make_float4(x[0], x[1], x[2], x[3]);
    *reinterpret_cast<float4*>(o + 4) = make_float4(x[4], x[5], x[6], x[7]);
  }
  __syncthreads();
  float Aval[4][4];
  {
    f32x4 akk[4], aqk[4];
#pragma unroll
    for (int ct = 0; ct < 4; ++ct) { akk[ct] = f32x4{0, 0, 0, 0}; aqk[ct] = f32x4{0, 0, 0, 0}; }
#pragma unroll
    for (int ks = 0; ks < 4; ++ks) {
      const bf16x8 bk = ldfrag(k_s + (16 * w + fr) * 136 + ks * 32 + fq * 8);
      const bf16x8 bq = ldfrag(q_s + (16 * w + fr) * 136 + ks * 32 + fq * 8);
#pragma unroll
      for (int ct = 0; ct < 4; ++ct) {
        const bf16x8 a = ldfrag(k_s + (ct * 16 + fr) * 136 + ks * 32 + fq * 8);
        akk[ct] = mfma16(a, bk, akk[ct]);
        aqk[ct] = mfma16(a, bq, aqk[ct]);
      }
    }
    const int i = 16 * w + fr;
    const float gi = gc[i], bi = bt[i];
#pragma unroll
    for (int ct = 0; ct < 4; ++ct) {
      float qv[4];
#pragma unroll
      for (int j = 0; j < 4; ++j) {
        const int jj = ct * 16 + fq * 4 + j;
        const float d = (i >= jj) ? __expf(gi - gc[jj]) : 0.f;
        Aval[ct][j] = (i > jj) ? akk[ct][j] * d * bi : 0.f;
        qv[j] = aqk[ct][j] * d;
      }
      *reinterpret_cast<uint2*>(p.g_QK + (size_t)pit * 4096 + i * 64 + ct * 16 + fq * 4) = pack4(qv[0], qv[1], qv[2], qv[3]);
    }
  }
  __syncthreads();
  {
    const int i = 16 * w + fr;
#pragma unroll
    for (int ct = 0; ct < 4; ++ct)
#pragma unroll
      for (int j = 0; j < 4; ++j) A_s[(ct * 16 + fq * 4 + j) * 64 + i] = Aval[ct][j];
  }
  __syncthreads();
  float* T_f = (float*)k_s;
  bf16_t* T_b = q_s;
  if (w == 0) {
    const int c = lane;
    for (int rb = 0; rb < 4; ++rb) {
      float acc[16];
#pragma unroll
      for (int ii = 0; ii < 16; ++ii) acc[ii] = (16 * rb + ii == c) ? 1.f : 0.f;
      for (int j = 0; j < 16 * rb; ++j) {
        const float tj = T_f[j * 64 + c];
        const float* ap = A_s + j * 64 + 16 * rb;
        const float4 a0 = *reinterpret_cast<const float4*>(ap), a1 = *reinterpret_cast<const float4*>(ap + 4);
        const float4 a2 = *reinterpret_cast<const float4*>(ap + 8), a3 = *reinterpret_cast<const float4*>(ap + 12);
        acc[0] -= a0.x * tj; acc[1] -= a0.y * tj; acc[2] -= a0.z * tj; acc[3] -= a0.w * tj;
        acc[4] -= a1.x * tj; acc[5] -= a1.y * tj; acc[6] -= a1.z * tj; acc[7] -= a1.w * tj;
        acc[8] -= a2.x * tj; acc[9] -= a2.y * tj; acc[10] -= a2.z * tj; acc[11] -= a2.w * tj;
        acc[12] -= a3.x * tj; acc[13] -= a3.y * tj; acc[14] -= a3.z * tj; acc[15] -= a3.w * tj;
      }
#pragma unroll
      for (int jj = 0; jj < 16; ++jj) {
        const float tj = acc[jj];
        const float* ap = A_s + (16 * rb + jj) * 64 + 16 * rb;
        const float4 a0 = *reinterpret_cast<const float4*>(ap), a1 = *reinterpret_cast<const float4*>(ap + 4);
        const float4 a2 = *reinterpret_cast<const float4*>(ap + 8), a3 = *reinterpret_cast<const float4*>(ap + 12);
        const float av[16] = {a0.x, a0.y, a0.z, a0.w, a1.x, a1.y, a1.z, a1.w, a2.x, a2.y, a2.z, a2.w, a3.x, a3.y, a3.z, a3.w};
#pragma unroll
        for (int ii = 0; ii < 16; ++ii) if (ii > jj) acc[ii] -= av[ii] * tj;
      }
#pragma unroll
      for (int ii = 0; ii < 16; ++ii) T_f[(16 * rb + ii) * 64 + c] = acc[ii];
    }
  }
  __syncthreads();
  {
    const int i = tid >> 2, c0 = (tid & 3) * 16;
    float v[16];
#pragma unroll
    for (int e = 0; e < 16; ++e) v[e] = T_f[i * 64 + c0 + e] * bt[c0 + e];
    *reinterpret_cast<uint4*>(T_b + i * 72 + c0) = pack8(v);
    *reinterpret_cast<uint4*>(T_b + i * 72 + c0 + 8) = pack8(v + 8);
  }
  __syncthreads();
  {
    f32x4 ua[8];
#pragma unroll
    for (int nt = 0; nt < 8; ++nt) ua[nt] = f32x4{0, 0, 0, 0};
#pragma unroll
    for (int ks = 0; ks < 2; ++ks) {
      const bf16x8 a = ldfrag(T_b + (16 * w + fr) * 72 + ks * 32 + fq * 8);
#pragma unroll
      for (int nt = 0; nt < 8; ++nt) ua[nt] = mfma16(a, ldfrag(vT + (nt * 16 + fr) * 72 + ks * 32 + fq * 8), ua[nt]);
    }
#pragma unroll
    for (int nt = 0; nt < 8; ++nt)
      *reinterpret_cast<uint2*>(p.g_U + (size_t)pit * 8192 + ((w * 8 + nt) * 64 + lane) * 4) = pack4(ua[nt][0], ua[nt][1], ua[nt][2], ua[nt][3]);
  }
  __syncthreads();
  {
    const int i = tid >> 2, c0 = (tid & 3) * 16;
    float v[16];
#pragma unroll
    for (int e = 0; e < 16; ++e) v[e] = T_f[i * 64 + c0 + e] * bt[c0 + e] * eg[c0 + e];
    *reinterpret_cast<uint4*>(T_b + i * 72 + c0) = pack8(v);
    *reinterpret_cast<uint4*>(T_b + i * 72 + c0 + 8) = pack8(v + 8);
  }
  __syncthreads();
  {
    f32x4 wa[8];
#pragma unroll
    for (int mt = 0; mt < 8; ++mt) wa[mt] = f32x4{0, 0, 0, 0};
#pragma unroll
    for (int ks = 0; ks < 2; ++ks) {
      const bf16x8 bfr = ldfrag(T_b + (16 * w + fr) * 72 + ks * 32 + fq * 8);
#pragma unroll
      for (int mt = 0; mt < 8; ++mt) wa[mt] = mfma16(ldfrag(kT + (mt * 16 + fr) * 72 + ks * 32 + fq * 8), bfr, wa[mt]);
    }
#pragma unroll
    for (int mt = 0; mt < 8; ++mt)
      *reinterpret_cast<uint2*>(p.g_W + (size_t)pit * 8192 + (16 * w + fr) * 128 + mt * 16 + fq * 4) = pack4(wa[mt][0], wa[mt][1], wa[mt][2], wa[mt][3]);
  }
#pragma unroll
  for (int i = 0; i < 4; ++i) {
    const int id = tid + 256 * i, r = id >> 3, c = id & 7;
    *reinterpret_cast<uint4*>(p.g_KT + (size_t)pit * 8192 + r * 64 + c * 8) = *reinterpret_cast<const uint4*>(kT + r * 72 + c * 8);
  }
  if (tid < 64) p.g_GS[(size_t)pit * 128 + tid] = __expf(glast - gc[tid]);
  if (tid == 64) p.g_GS[(size_t)pit * 128 + 64] = __expf(glast);
  __syncthreads();
}

__device__ __forceinline__ void ret_pre(const Params& p, int item, unsigned char* smraw) {
  const int tid = threadIdx.x, lane = tid & 63, w = tid >> 6;
  const int fr = lane & 15, fq = lane >> 4;
  const int h = item & 3, n = (item >> 2) & 31, b = item >> 7;
  const int pit = (b * 4 + h) * 32 + n;
  bf16_t* q_s = (bf16_t*)smraw;
  bf16_t* k_s = q_s + 64 * 136;
  bf16_t* kT = k_s + 64 * 136;
  const float log_g = log1pf(-exp2f(-5.f - (float)h));
#pragma unroll
  for (int i = 0; i < 2; ++i) {
    const int id = tid + 256 * i, r = id >> 3, cc = id & 7;
    const int pos = n * 64 + r;
    float cs[8], sn[8];
    {
      const float4 c0 = *reinterpret_cast<const float4*>(p.ropec + pos * 64 + cc * 8);
      const float4 c1 = *reinterpret_cast<const float4*>(p.ropec + pos * 64 + cc * 8 + 4);
      const float4 s0 = *reinterpret_cast<const float4*>(p.ropes + pos * 64 + cc * 8);
      const float4 s1 = *reinterpret_cast<const float4*>(p.ropes + pos * 64 + cc * 8 + 4);
      cs[0] = c0.x; cs[1] = c0.y; cs[2] = c0.z; cs[3] = c0.w; cs[4] = c1.x; cs[5] = c1.y; cs[6] = c1.z; cs[7] = c1.w;
      sn[0] = s0.x; sn[1] = s0.y; sn[2] = s0.z; sn[3] = s0.w; sn[4] = s1.x; sn[5] = s1.y; sn[6] = s1.z; sn[7] = s1.w;
    }
    const size_t grow = ((size_t)b * 2048 + pos) * 1024;
#pragma unroll
    for (int mat = 0; mat < 2; ++mat) {
      const bf16_t* src = p.P_rqk + grow + mat * 512 + h * 128;
      float x1[8], x2[8], o1[8], o2[8];
      unpack8(*reinterpret_cast<const uint4*>(src + cc * 8), x1);
      unpack8(*reinterpret_cast<const uint4*>(src + 64 + cc * 8), x2);
      const float sc = mat ? 0.08838834764831845f : 1.f;
#pragma unroll
      for (int e = 0; e < 8; ++e) {
        o1[e] = (x1[e] * cs[e] - x2[e] * sn[e]) * sc;
        o2[e] = (x1[e] * sn[e] + x2[e] * cs[e]) * sc;
      }
      if (mat == 0) {
        *reinterpret_cast<uint4*>(q_s + r * 136 + cc * 8) = pack8(o1);
        *reinterpret_cast<uint4*>(q_s + r * 136 + 64 + cc * 8) = pack8(o2);
        const float qd = __expf((float)(r + 1) * log_g);
#pragma unroll
        for (int e = 0; e < 8; ++e) { o1[e] *= qd; o2[e] *= qd; }
        *reinterpret_cast<uint4*>(p.r_QD + (size_t)pit * 8192 + r * 128 + cc * 8) = pack8(o1);
        *reinterpret_cast<uint4*>(p.r_QD + (size_t)pit * 8192 + r * 128 + 64 + cc * 8) = pack8(o2);
      } else {
        *reinterpret_cast<uint4*>(k_s + r * 136 + cc * 8) = pack8(o1);
        *reinterpret_cast<uint4*>(k_s + r * 136 + 64 + cc * 8) = pack8(o2);
        const float kd = __expf((float)(63 - r) * log_g);
#pragma unroll
        for (int e = 0; e < 8; ++e) {
          kT[(cc * 8 + e) * 72 + r] = f2bf(o1[e] * kd);
          kT[(64 + cc * 8 + e) * 72 + r] = f2bf(o2[e] * kd);
        }
      }
    }
  }
  __syncthreads();
  {
    f32x4 sc[4];
#pragma unroll
    for (int ct = 0; ct < 4; ++ct) sc[ct] = f32x4{0, 0, 0, 0};
#pragma unroll
    for (int ks = 0; ks < 4; ++ks) {
      const bf16x8 bq = ldfrag(q_s + (16 * w + fr) * 136 + ks * 32 + fq * 8);
#pragma unroll
      for (int ct = 0; ct < 4; ++ct) sc[ct] = mfma16(ldfrag(k_s + (ct * 16 + fr) * 136 + ks * 32 + fq * 8), bq, sc[ct]);
    }
    const int i = 16 * w + fr;
#pragma unroll
    for (int ct = 0; ct < 4; ++ct) {
      float v[4];
#pragma unroll
      for (int j = 0; j < 4; ++j) {
        const int jj = ct * 16 + fq * 4 + j;
        v[j] = (i >= jj) ? sc[ct][j] * __expf((float)(i - jj) * log_g) : 0.f;
      }
      *reinterpret_cast<uint2*>(p.r_SC + (size_t)pit * 4096 + i * 64 + ct * 16 + fq * 4) = pack4(v[0], v[1], v[2], v[3]);
    }
  }
#pragma unroll
  for (int i = 0; i < 4; ++i) {
    const int id = tid + 256 * i, r = id >> 3, c = id & 7;
    *reinterpret_cast<uint4*>(p.r_KDT + (size_t)pit * 8192 + r * 64 + c * 8) = *reinterpret_cast<const uint4*>(kT + r * 72 + c * 8);
  }
  __syncthreads();
}

__device__ __forceinline__ void phase2(const Params& p, unsigned char* smraw) {
  const int G = gridDim.x;
#ifndef P2MASK
#define P2MASK 3
#endif
  if (P2MASK & 1) for (int it = first_item(0); it < 2048; it += G) gdn_pre(p, it, smraw);
  if (P2MASK & 2) for (int it = first_item(2048); it < 3072; it += G) ret_pre(p, it - 2048, smraw);
}

__device__ __forceinline__ void gdn_seq(const Params& p, int bh, int sl, unsigned char* smraw) {
  const int tid = threadIdx.x, lane = tid & 63, w = tid >> 6;
  const int fr = lane & 15, fq = lane >> 4;
  const int b = bh >> 3, h = bh & 7;
  bf16_t* ST = (bf16_t*)smraw;
  bf16_t* vT = ST + 32 * 136;
  bf16_t* vTs = vT + 32 * 72;
  f32x4 sacc[2][2];
#pragma unroll
  for (int a = 0; a < 2; ++a)
#pragma unroll
    for (int c = 0; c < 2; ++c) sacc[a][c] = f32x4{0, 0, 0, 0};
  for (int idx = tid; idx < 32 * 136 / 2; idx += 256) ((unsigned*)ST)[idx] = 0u;
  __syncthreads();
  struct Ops { bf16x8 wf[4], qhf[4], qkf[2], ktf[2][2]; uint2 uu[2]; float4 ds; float egl; };
  auto load = [&](Ops& o, int n) __attribute__((always_inline)) {
    const size_t item = (size_t)bh * 32 + n;
    const bf16_t* W = p.g_W + item * 8192 + (16 * w + fr) * 128 + fq * 8;
    const bf16_t* QH = p.g_QH + item * 8192 + (16 * w + fr) * 128 + fq * 8;
    const bf16_t* QK = p.g_QK + item * 4096 + (16 * w + fr) * 64 + fq * 8;
    const bf16_t* KT = p.g_KT + item * 8192 + (32 * w + fr) * 64 + fq * 8;
#pragma unroll
    for (int ks = 0; ks < 4; ++ks) { o.wf[ks] = ldfrag(W + ks * 32); o.qhf[ks] = ldfrag(QH + ks * 32); }
#pragma unroll
    for (int ks = 0; ks < 2; ++ks) {
      o.qkf[ks] = ldfrag(QK + ks * 32);
      o.ktf[0][ks] = ldfrag(KT + ks * 32);
      o.ktf[1][ks] = ldfrag(KT + 16 * 64 + ks * 32);
    }
#pragma unroll
    for (int nt = 0; nt < 2; ++nt) o.uu[nt] = *reinterpret_cast<const uint2*>(p.g_U + item * 8192 + ((w * 8 + sl * 2 + nt) * 64 + lane) * 4);
    o.ds = *reinterpret_cast<const float4*>(p.g_GS + item * 128 + 16 * w + fq * 4);
    o.egl = p.g_GS[item * 128 + 64];
  };
  auto step = [&](const Ops& o, int n) __attribute__((always_inline)) {
    f32x4 pacc[2];
#pragma unroll
    for (int nt = 0; nt < 2; ++nt) {
      pacc[nt] = f32x4{0, 0, 0, 0};
#pragma unroll
      for (int ks = 0; ks < 4; ++ks) pacc[nt] = mfma16(o.wf[ks], ldfrag(ST + (nt * 16 + fr) * 136 + ks * 32 + fq * 8), pacc[nt]);
    }
    const float dsv[4] = {o.ds.x, o.ds.y, o.ds.z, o.ds.w};
#pragma unroll
    for (int nt = 0; nt < 2; ++nt) {
      float u[4]; unpack4(o.uu[nt], u);
      float vn[4], vs[4];
#pragma unroll
      for (int j = 0; j < 4; ++j) { vn[j] = u[j] - pacc[nt][j]; vs[j] = vn[j] * dsv[j]; }
      *reinterpret_cast<uint2*>(vT + (nt * 16 + fr) * 72 + 16 * w + fq * 4) = pack4(vn[0], vn[1], vn[2], vn[3]);
      *reinterpret_cast<uint2*>(vTs + (nt * 16 + fr) * 72 + 16 * w + fq * 4) = pack4(vs[0], vs[1], vs[2], vs[3]);
    }
    __syncthreads();
    f32x4 oacc[2];
#pragma unroll
    for (int nt = 0; nt < 2; ++nt) {
      oacc[nt] = f32x4{0, 0, 0, 0};
#pragma unroll
      for (int ks = 0; ks < 4; ++ks) oacc[nt] = mfma16(ldfrag(ST + (nt * 16 + fr) * 136 + ks * 32 + fq * 8), o.qhf[ks], oacc[nt]);
#pragma unroll
      for (int ks = 0; ks < 2; ++ks) oacc[nt] = mfma16(ldfrag(vT + (nt * 16 + fr) * 72 + ks * 32 + fq * 8), o.qkf[ks], oacc[nt]);
    }
#pragma unroll
    for (int mt = 0; mt < 2; ++mt)
#pragma unroll
      for (int nt = 0; nt < 2; ++nt) {
#pragma unroll
        for (int j = 0; j < 4; ++j) sacc[mt][nt][j] *= o.egl;
#pragma unroll
        for (int ks = 0; ks < 2; ++ks) sacc[mt][nt] = mfma16(o.ktf[mt][ks], ldfrag(vTs + (nt * 16 + fr) * 72 + ks * 32 + fq * 8), sacc[mt][nt]);
      }
    {
      bf16_t* og = p.o_g + ((size_t)b * 2048 + n * 64 + 16 * w + fr) * 1024 + h * 128 + sl * 32 + fq * 4;
#pragma unroll
      for (int nt = 0; nt < 2; ++nt)
        *reinterpret_cast<uint2*>(og + nt * 16) = pack4(oacc[nt][0], oacc[nt][1], oacc[nt][2], oacc[nt][3]);
    }
    __syncthreads();
#pragma unroll
    for (int mt = 0; mt < 2; ++mt)
#pragma unroll
      for (int nt = 0; nt < 2; ++nt)
        *reinterpret_cast<uint2*>(ST + (nt * 16 + fr) * 136 + 32 * w + mt * 16 + fq * 4) = pack4(sacc[mt][nt][0], sacc[mt][nt][1], sacc[mt][nt][2], sacc[mt][nt][3]);
    __syncthreads();
  };
  Ops oa, ob;
  load(oa, 0);
  for (int n = 0; n < 32; n += 2) {
    load(ob, n + 1);
    step(oa, n);
    if (n + 2 < 32) load(oa, n + 2);
    step(ob, n + 1);
  }
  float* so = p.out + OUT_SG_P + ((size_t)bh * 128 + 32 * w + fq * 4) * 128 + sl * 32 + fr;
#pragma unroll
  for (int mt = 0; mt < 2; ++mt)
#pragma unroll
    for (int nt = 0; nt < 2; ++nt)
#pragma unroll
      for (int j = 0; j < 4; ++j) so[(size_t)(mt * 16 + j) * 128 + nt * 16] = sacc[mt][nt][j];
  __syncthreads();
}

__device__ __forceinline__ void ret_seq(const Params& p, int bh, int sl, unsigned char* smraw) {
  const int tid = threadIdx.x, lane = tid & 63, w = tid >> 6;
  const int fr = lane & 15, fq = lane >> 4;
  const int b = bh >> 2, h = bh & 3;
  bf16_t* ST = (bf16_t*)smraw;
  bf16_t* vT = ST + 32 * 136;
  const float log_g = log1pf(-exp2f(-5.f - (float)h));
  const float cd = __expf(64.f * log_g);
  f32x4 sacc[2][2];
#pragma unroll
  for (int a = 0; a < 2; ++a)
#pragma unroll
    for (int c = 0; c < 2; ++c) sacc[a][c] = f32x4{0, 0, 0, 0};
  struct Ops { bf16x8 qdf[4], scf[2], kdf[2][2]; uint4 vr; };
  const int vrow = tid >> 2, vc8 = (tid & 3) * 8;
  auto load = [&](Ops& o, int n) __attribute__((always_inline)) {
    const size_t item = (size_t)bh * 32 + n;
    const bf16_t* QD = p.r_QD + item * 8192 + (16 * w + fr) * 128 + fq * 8;
    const bf16_t* SC = p.r_SC + item * 4096 + (16 * w + fr) * 64 + fq * 8;
    const bf16_t* KD = p.r_KDT + item * 8192 + (32 * w + fr) * 64 + fq * 8;
#pragma unroll
    for (int ks = 0; ks < 4; ++ks) o.qdf[ks] = ldfrag(QD + ks * 32);
#pragma unroll
    for (int ks = 0; ks < 2; ++ks) {
      o.scf[ks] = ldfrag(SC + ks * 32);
      o.kdf[0][ks] = ldfrag(KD + ks * 32);
      o.kdf[1][ks] = ldfrag(KD + 16 * 64 + ks * 32);
    }
    o.vr = *reinterpret_cast<const uint4*>(p.P_rv + ((size_t)b * 2048 + n * 64 + vrow) * 1024 + h * 256 + sl * 32 + vc8);
  };
  auto step = [&](const Ops& o, int n) __attribute__((always_inline)) {
    {
      float v8[8]; unpack8(o.vr, v8);
#pragma unroll
      for (int e = 0; e < 8; ++e) vT[(vc8 + e) * 72 + vrow] = f2bf(v8[e]);
    }
#pragma unroll
    for (int mt = 0; mt < 2; ++mt)
#pragma unroll
      for (int nt = 0; nt < 2; ++nt)
        *reinterpret_cast<uint2*>(ST + (nt * 16 + fr) * 136 + 32 * w + mt * 16 + fq * 4) = pack4(sacc[mt][nt][0], sacc[mt][nt][1], sacc[mt][nt][2], sacc[mt][nt][3]);
    __syncthreads();
    f32x4 oacc[2];
#pragma unroll
    for (int nt = 0; nt < 2; ++nt) {
      oacc[nt] = f32x4{0, 0, 0, 0};
#pragma unroll
      for (int ks = 0; ks < 4; ++ks) oacc[nt] = mfma16(ldfrag(ST + (nt * 16 + fr) * 136 + ks * 32 + fq * 8), o.qdf[ks], oacc[nt]);
#pragma unroll
      for (int ks = 0; ks < 2; ++ks) oacc[nt] = mfma16(ldfrag(vT + (nt * 16 + fr) * 72 + ks * 32 + fq * 8), o.scf[ks], oacc[nt]);
    }
#pragma unroll
    for (int mt = 0; mt < 2; ++mt)
#pragma unroll
      for (int nt = 0; nt < 2; ++nt) {
#pragma unroll
        for (int j = 0; j < 4; ++j) sacc[mt][nt][j] *= cd;
#pragma unroll
        for (int ks = 0; ks < 2; ++ks) sacc[mt][nt] = mfma16(o.kdf[mt][ks], ldfrag(vT + (nt * 16 + fr) * 72 + ks * 32 + fq * 8), sacc[mt][nt]);
      }
    {
      bf16_t* og = p.o_r + ((size_t)b * 2048 + n * 64 + 16 * w + fr) * 1024 + h * 256 + sl * 32 + fq * 4;
#pragma unroll
      for (int nt = 0; nt < 2; ++nt)
        *reinterpret_cast<uint2*>(og + nt * 16) = pack4(oacc[nt][0], oacc[nt][1], oacc[nt][2], oacc[nt][3]);
    }
    __syncthreads();
  };
  Ops oa, ob;
  load(oa, 0);
  for (int n = 0; n < 32; n += 2) {
    load(ob, n + 1);
    step(oa, n);
    if (n + 2 < 32) load(oa, n + 2);
    step(ob, n + 1);
  }
  float* so = p.out + OUT_SR_P + ((size_t)bh * 128 + 32 * w + fq * 4) * 256 + sl * 32 + fr;
#pragma unroll
  for (int mt = 0; mt < 2; ++mt)
#pragma unroll
    for (int nt = 0; nt < 2; ++nt)
#pragma unroll
      for (int j = 0; j < 4; ++j) so[(size_t)(mt * 16 + j) * 256 + nt * 16] = sacc[mt][nt][j];
}

__device__ __forceinline__ void ret_sample(const Params& p, int item, unsigned char* smraw) {
  const int tid = threadIdx.x, lane = tid & 63, w = tid >> 6;
  const int b = item >> 2, h = item & 3;
  const size_t row = NPR + b;
  float* qs = (float*)smraw;
  float* ks = qs + 128;
  float* red = ks + 128;
  const float gam = 1.f - exp2f(-5.f - (float)h);
  if (tid < 128) {
    const int mat = tid >> 6, i = tid & 63;
    const bf16_t* src = p.P_rqk + row * 1024 + mat * 512 + h * 128;
    const float x1 = bf2f(src[i]), x2 = bf2f(src[i + 64]);
    const float c = p.ropec[2048 * 64 + i], s = p.ropes[2048 * 64 + i];
    const float sc = mat ? 0.08838834764831845f : 1.f;
    float* d = mat ? ks : qs;
    d[i] = (x1 * c - x2 * s) * sc;
    d[i + 64] = (x1 * s + x2 * c) * sc;
  }
  __syncthreads();
  const int c4 = lane * 4;
  float v4[4];
  unpack4(*reinterpret_cast<const uint2*>(p.P_rv + row * 1024 + h * 256 + c4), v4);
  const float* S = p.state_ret + ((size_t)(b * 4 + h) * 128) * 256;
  float* So = p.out + OUT_SR_S + ((size_t)(b * 4 + h) * 128) * 256;
  float o0 = 0.f, o1 = 0.f, o2 = 0.f, o3 = 0.f;
#pragma unroll 8
  for (int i = 0; i < 32; ++i) {
    const int k = w + 4 * i;
    const float4 s = ldnt4(S + (size_t)k * 256 + c4);
    const float kk = ks[k], qq = qs[k];
    float4 sn;
    sn.x = gam * s.x + kk * v4[0]; sn.y = gam * s.y + kk * v4[1]; sn.z = gam * s.z + kk * v4[2]; sn.w = gam * s.w + kk * v4[3];
    stnt4(So + (size_t)k * 256 + c4, sn);
    o0 += qq * sn.x; o1 += qq * sn.y; o2 += qq * sn.z; o3 += qq * sn.w;
  }
  *reinterpret_cast<float4*>(red + w * 256 + c4) = make_float4(o0, o1, o2, o3);
  __syncthreads();
  {
    const float o = red[tid] + red[256 + tid] + red[512 + tid] + red[768 + tid];
    p.o_r[row * 1024 + h * 256 + tid] = f2bf(o);
  }
  __syncthreads();
}

__device__ __forceinline__ void gdn_sample(const Params& p, int item, unsigned char* smraw) {
  const int tid = threadIdx.x, lane = tid & 63, w = tid >> 6;
  const int b = item >> 3, h = item & 7;
  const size_t row = NPR + b;
  float* cv = (float*)smraw;
  float* red = cv + 384;
  float* misc = red + 2048;
  for (int ch = tid; ch < 384; ch += 256) {
    const int mat = ch >> 7, c = ch & 127;
    const int col = mat * 1024 + h * 128 + c;
    const float x = bf2f(p.P_qkv[row * 3072 + col]);
    const float b0 = p.state_conv[((size_t)b * 3 + 0) * 3072 + col];
    const float b1 = p.state_conv[((size_t)b * 3 + 1) * 3072 + col];
    const float b2 = p.state_conv[((size_t)b * 3 + 2) * 3072 + col];
    float o = p.conv_w[col] * b0 + p.conv_w[3072 + col] * b1 + p.conv_w[2 * 3072 + col] * b2 + p.conv_w[3 * 3072 + col] * x;
    cv[ch] = siluf_(o);
    float* so = p.out + OUT_SC_S + (size_t)b * 3 * 3072 + col;
    so[0] = b1; so[3072] = b2; so[2 * 3072] = x;
  }
  __syncthreads();
  if (w < 2) {
    const float a = cv[w * 128 + lane], c = cv[w * 128 + 64 + lane];
    float ss = wave_sum(a * a + c * c);
    float sc = rsqrtf(ss + EPSF);
    if (w == 0) sc *= 0.08838834764831845f;
    cv[w * 128 + lane] = a * sc; cv[w * 128 + 64 + lane] = c * sc;
  }
  __syncthreads();
  if (w == 0) {
    const float d = wave_sum(cv[lane] * cv[128 + lane] + cv[64 + lane] * cv[192 + lane]);
    if (lane == 0) misc[0] = d;
  }
  const float beta = p.beta[row * 8 + h];
  const float eg = __expf(p.gl[row * 8 + h]);
  const int c4 = (tid & 31) * 4, rg = tid >> 5;
  const float* S = p.state_gdn + ((size_t)(b * 8 + h) * 128) * 128;
  float* So = p.out + OUT_SG_S + ((size_t)(b * 8 + h) * 128) * 128;
  float4 s[16];
  float kS[4] = {0, 0, 0, 0}, qS[4] = {0, 0, 0, 0};
#pragma unroll
  for (int i = 0; i < 16; ++i) {
    const int k = rg + 8 * i;
    s[i] = ldnt4(S + (size_t)k * 128 + c4);
  }
#pragma unroll
  for (int i = 0; i < 16; ++i) {
    const int k = rg + 8 * i;
    const float kk = cv[128 + k], qq = cv[k];
    kS[0] += kk * s[i].x; kS[1] += kk * s[i].y; kS[2] += kk * s[i].z; kS[3] += kk * s[i].w;
    qS[0] += qq * s[i].x; qS[1] += qq * s[i].y; qS[2] += qq * s[i].z; qS[3] += qq * s[i].w;
  }
  *reinterpret_cast<float4*>(red + rg * 128 + c4) = make_float4(kS[0], kS[1], kS[2], kS[3]);
  *reinterpret_cast<float4*>(red + 1024 + rg * 128 + c4) = make_float4(qS[0], qS[1], qS[2], qS[3]);
  __syncthreads();
  float kSt[4] = {0, 0, 0, 0}, qSt[4] = {0, 0, 0, 0};
#pragma unroll
  for (int g = 0; g < 8; ++g) {
    const float4 a = *reinterpret_cast<const float4*>(red + g * 128 + c4);
    const float4 c = *reinterpret_cast<const float4*>(red + 1024 + g * 128 + c4);
    kSt[0] += a.x; kSt[1] += a.y; kSt[2] += a.z; kSt[3] += a.w;
    qSt[0] += c.x; qSt[1] += c.y; qSt[2] += c.z; qSt[3] += c.w;
  }
  const float qk = misc[0];
  float vn[4], o[4];
#pragma unroll
  for (int e = 0; e < 4; ++e) {
    vn[e] = beta * (cv[256 + c4 + e] - eg * kSt[e]);
    o[e] = eg * qSt[e] + qk * vn[e];
  }
#pragma unroll
  for (int i = 0; i < 16; ++i) {
    const int k = rg + 8 * i;
    const float kk = cv[128 + k];
    float4 sn;
    sn.x = eg * s[i].x + kk * vn[0]; sn.y = eg * s[i].y + kk * vn[1]; sn.z = eg * s[i].z + kk * vn[2]; sn.w = eg * s[i].w + kk * vn[3];
    stnt4(So + (size_t)k * 128 + c4, sn);
  }
  if (rg == 0) *reinterpret_cast<uint2*>(p.o_g + row * 1024 + h * 128 + c4) = pack4(o[0], o[1], o[2], o[3]);
  __syncthreads();
}

__device__ __forceinline__ void phase3(const Params& p, unsigned char* smraw) {
  const int G = gridDim.x;
#ifndef P3MASK
#define P3MASK 15
#endif
  const bool late_seq = (blockIdx.x & 256) != 0;
  if (!late_seq) {
    if (P3MASK & 1) for (int it = first_item(0); it < 256; it += G) gdn_seq(p, it & 63, it >> 6, smraw);
  }
  if (P3MASK & 4) for (int it = first_item(512); it < 1024; it += G) ret_sample(p, it - 512, smraw);
  if (P3MASK & 8) for (int it = first_item(1024); it < 2048; it += G) gdn_sample(p, it - 1024, smraw);
  if (P3MASK & 2) for (int it = first_item(256); it < 512; it += G) ret_seq(p, (it - 256) & 31, (it - 256) >> 5, smraw);
  if (late_seq) {
    if (P3MASK & 1) for (int it = first_item(0); it < 256; it += G) gdn_seq(p, it & 63, it >> 6, smraw);
  }
}

__device__ __forceinline__ void phase4(const Params& p) {
  const int tid = threadIdx.x, lane = tid & 63, wid = tid >> 6;
  for (int r = blockIdx.x * 4 + wid; r < NTOK; r += gridDim.x * 4) {
    const size_t base = (size_t)r * 1024;
    uint4 ro[2], rg[2], go[2], gz[2];
#pragma unroll
    for (int q = 0; q < 2; ++q) {
      const int c = q * 512 + lane * 8;
      ro[q] = *reinterpret_cast<const uint4*>(p.o_r + base + c);
      rg[q] = *reinterpret_cast<const uint4*>(p.P_rg + base + c);
      go[q] = *reinterpret_cast<const uint4*>(p.o_g + base + c);
      gz[q] = *reinterpret_cast<const uint4*>(p.P_z + base + c);
    }
#pragma unroll
    for (int q = 0; q < 2; ++q) {
      const int c = q * 512 + lane * 8;
      float o[8], g[8];
      unpack8(ro[q], o); unpack8(rg[q], g);
      float sm_ = 0.f;
#pragma unroll
      for (int e = 0; e < 8; ++e) sm_ += o[e];
      sm_ += __shfl_xor(sm_, 1); sm_ += __shfl_xor(sm_, 2); sm_ += __shfl_xor(sm_, 4); sm_ += __shfl_xor(sm_, 8); sm_ += __shfl_xor(sm_, 16);
      const float mu = sm_ * (1.f / 256.f);
      float vs = 0.f;
#pragma unroll
      for (int e = 0; e < 8; ++e) { o[e] -= mu; vs += o[e] * o[e]; }
      vs += __shfl_xor(vs, 1); vs += __shfl_xor(vs, 2); vs += __shfl_xor(vs, 4); vs += __shfl_xor(vs, 8); vs += __shfl_xor(vs, 16);
      const float rs = rsqrtf(vs * (1.f / 256.f) + EPSF);
      const float4 g0 = *reinterpret_cast<const float4*>(p.ret_gn_g + c), g1 = *reinterpret_cast<const float4*>(p.ret_gn_g + c + 4);
      const float gn[8] = {g0.x, g0.y, g0.z, g0.w, g1.x, g1.y, g1.z, g1.w};
      float y[8];
#pragma unroll
      for (int e = 0; e < 8; ++e) y[e] = siluf_(g[e]) * o[e] * rs * gn[e];
      *reinterpret_cast<uint4*>(p.ya + base + c) = pack8(y);
    }
#pragma unroll
    for (int q = 0; q < 2; ++q) {
      const int c = q * 512 + lane * 8;
      float o[8], z[8];
      unpack8(go[q], o); unpack8(gz[q], z);
      float ss = 0.f;
#pragma unroll
      for (int e = 0; e < 8; ++e) ss += o[e] * o[e];
      ss += __shfl_xor(ss, 1); ss += __shfl_xor(ss, 2); ss += __shfl_xor(ss, 4); ss += __shfl_xor(ss, 8);
      const float rs = rsqrtf(ss * (1.f / 128.f) + EPSF);
      const int d = (lane & 15) * 8;
      const float4 g0 = *reinterpret_cast<const float4*>(p.gdn_norm_g + d), g1 = *reinterpret_cast<const float4*>(p.gdn_norm_g + d + 4);
      const float gn[8] = {g0.x, g0.y, g0.z, g0.w, g1.x, g1.y, g1.z, g1.w};
      float y[8];
#pragma unroll
      for (int e = 0; e < 8; ++e) y[e] = o[e] * rs * gn[e] * siluf_(z[e]);
      *reinterpret_cast<uint4*>(p.yb + base + c) = pack8(y);
    }
  }
}

__device__ __forceinline__ float row_rs(const float* ss, int row) {
  const float4 a = *reinterpret_cast<const float4*>(ss + (size_t)row * 16);
  const float4 b = *reinterpret_cast<const float4*>(ss + (size_t)row * 16 + 4);
  const float4 c = *reinterpret_cast<const float4*>(ss + (size_t)row * 16 + 8);
  const float4 d = *reinterpret_cast<const float4*>(ss + (size_t)row * 16 + 12);
  const float s = ((a.x + a.y) + (a.z + a.w)) + ((b.x + b.y) + (b.z + b.w)) + ((c.x + c.y) + (c.z + c.w)) + ((d.x + d.y) + (d.z + d.w));
  return rsqrtf(s * (1.f / 1024.f) + EPSF);
}

#define SK_TILES 92
template <int MODE> struct SkOff { static constexpr int v = (MODE == 5) ? 0 : (MODE == 6) ? 16 : (MODE == 7) ? 24 : (MODE == 9) ? 32 : (MODE == 11) ? 40 : 48; };

template <int MODE>
__device__ __forceinline__ void gemm_epi(const Params& p, f32x4 (&acc)[4][4], int mt, int nt) {
  int tid_ = threadIdx.x;
  asm volatile("" : "+v"(tid_));
  const int tid = tid_, lane = tid & 63, wid = tid >> 6;
  const int wr = wid >> 1, wc = wid & 1, fr = lane & 15, fq = lane >> 4;
  const int row0 = mt * 128 + wr * 64 + fr;
  const int colb = nt * 128 + wc * 64 + fq * 4;
  if (MODE == 6 || MODE == 9 || MODE == 11) {
    bf16_t* xb = (MODE == 6) ? p.x1b : p.x2b;
    float* ssp = (MODE == 6) ? p.ss1 : (MODE == 9) ? p.ss2 : p.ss3;
#pragma unroll
    for (int ri = 0; ri < 4; ++ri) {
      const int row = row0 + ri * 16;
      float ssq = 0.f;
#pragma unroll
      for (int ci = 0; ci < 4; ++ci) {
        const size_t off = (size_t)row * 1024 + colb + ci * 16;
        float4 xin;
        if (MODE == 6) {
          const float* xs = (row < NPR) ? (p.x_prompt + off) : (p.x_sample + (off - (size_t)NPR * 1024));
          xin = *reinterpret_cast<const float4*>(xs);
        } else xin = *reinterpret_cast<const float4*>(p.out + off);
        float4 v = make_float4(xin.x + acc[ci][ri][0], xin.y + acc[ci][ri][1], xin.z + acc[ci][ri][2], xin.w + acc[ci][ri][3]);
        *reinterpret_cast<float4*>(p.out + off) = v;
        if (MODE != 11) *reinterpret_cast<uint2*>(xb + off) = pack4(v.x, v.y, v.z, v.w);
        ssq += v.x * v.x + v.y * v.y + v.z * v.z + v.w * v.w;
      }
      ssq += __shfl_xor(ssq, 16); ssq += __shfl_xor(ssq, 32);
      if (fq == 0) ssp[(size_t)row * 16 + nt * 2 + wc] = ssq;
    }
  } else if (MODE == 7) {
#pragma unroll
    for (int ri = 0; ri < 4; ++ri) {
      const int row = row0 + ri * 16;
      const float rs = row_rs(p.ss1, row);
#pragma unroll
      for (int ci = 0; ci < 4; ++ci) {
        const size_t off = (size_t)row * 1024 + colb + ci * 16;
        *reinterpret_cast<uint2*>(p.q + off) = pack4(acc[ci][ri][0] * rs, acc[ci][ri][1] * rs, acc[ci][ri][2] * rs, acc[ci][ri][3] * rs);
      }
    }
  } else if (MODE == 10) {
#pragma unroll
    for (int ri = 0; ri < 4; ++ri) {
      const int row = row0 + ri * 16;
      const float rs = row_rs(p.ss2, row);
#pragma unroll
      for (int ci = 0; ci < 4; ++ci) {
        const int f = (colb + ci * 16) >> 1;
        const float g0 = acc[ci][ri][0] * rs, u0 = acc[ci][ri][1] * rs, g1 = acc[ci][ri][2] * rs, u1 = acc[ci][ri][3] * rs;
        *reinterpret_cast<unsigned*>(p.ff + (size_t)row * 2816 + f) = pack2(siluf_(g0) * u0, siluf_(g1) * u1);
      }
    }
  }
}

template <int MODE>
__device__ __forceinline__ void gemm_phase(const Params& p, unsigned char* smraw) {
  const int tid = threadIdx.x, lane = tid & 63, wid = tid >> 6;
  const int wr = wid >> 1, wc = wid & 1, fr = lane & 15, fq = lane >> 4;
  bf16_t* sm = (bf16_t*)smraw;
  constexpr int NT = (MODE == 10) ? 44 : 8;
  constexpr int K = (MODE == 11) ? 2816 : 1024;
  const bf16_t* Aop = (MODE == 5) ? p.ya : (MODE == 6) ? p.merged : (MODE == 7) ? p.x1b : (MODE == 9) ? p.ao : (MODE == 10) ? p.x2b : p.ff;
  const bf16_t* Bop = (MODE == 5) ? p.Wt_a : (MODE == 6) ? p.Wt_out : (MODE == 7) ? p.Wt_xq : (MODE == 9) ? p.Wt_xo : (MODE == 10) ? p.Wt_gu : p.Wt_down;
  {
    const int total = 128 * NT;
    int t0, t1, tstep;
    tile_range(total, t0, t1, tstep);
    bool pre = false;
    for (int t = t0; t < t1; t += tstep) {
      int mt, nt;
      tile_decode(t, 128, NT, mt, nt);
      const bool has_next = (t + tstep < t1);
      int nmt = 0, nnt = 0;
      if (has_next) tile_decode(t + tstep, 128, NT, nmt, nnt);
      f32x4 acc[4][4];
      ZERO_ACC(acc);
      const size_t arow = (size_t)mt * 128;
      const size_t narow = (size_t)nmt * 128;
      if (MODE == 5) {
        int tq = threadIdx.x;
        asm volatile("" : "+v"(tq));
        const int row0 = mt * 128 + ((tq >> 7) & 1) * 64 + (tq & 15);
        const int colb = nt * 128 + ((tq >> 6) & 1) * 64 + ((tq >> 4) & 3) * 4;
        gemm_acc(acc, p.ya + arow * 1024, 1024, p.Wt_a + (size_t)nt * 128 * 1024, 1024, 1024, sm, pre,
                 p.yb + arow * 1024, 1024, p.Wt_b + (size_t)nt * 128 * 1024, 1024);
#pragma unroll
        for (int ci = 0; ci < 4; ++ci)
#pragma unroll
          for (int ri = 0; ri < 4; ++ri) {
            const size_t off = (size_t)(row0 + ri * 16) * 1024 + colb + ci * 16;
            float ga[4], gb[4];
            unpack4(*reinterpret_cast<const uint2*>(p.P_ga + off), ga);
            unpack4(*reinterpret_cast<const uint2*>(p.P_gb + off), gb);
#pragma unroll
            for (int j = 0; j < 4; ++j) acc[ci][ri][j] *= (1.f + __expf(-gb[j])) / (1.f + __expf(-ga[j]));
            asm volatile("" ::: "memory");
          }
        gemm_acc(acc, p.yb + arow * 1024, 1024, p.Wt_b + (size_t)nt * 128 * 1024, 1024, 1024, sm, true,
                 has_next ? p.ya + narow * 1024 : nullptr, 1024, p.Wt_a + (size_t)nnt * 128 * 1024, 1024);
        pre = has_next;
#pragma unroll
        for (int ci = 0; ci < 4; ++ci)
#pragma unroll
          for (int ri = 0; ri < 4; ++ri) {
            const size_t off = (size_t)(row0 + ri * 16) * 1024 + colb + ci * 16;
            float gb[4];
            unpack4(*reinterpret_cast<const uint2*>(p.P_gb + off), gb);
            *reinterpret_cast<uint2*>(p.merged + off) = pack4(acc[ci][ri][0] * sigmoidf_(gb[0]), acc[ci][ri][1] * sigmoidf_(gb[1]),
                                                              acc[ci][ri][2] * sigmoidf_(gb[2]), acc[ci][ri][3] * sigmoidf_(gb[3]));
            asm volatile("" ::: "memory");
          }
      } else {
        gemm_acc(acc, Aop + arow * K, K, Bop + (size_t)nt * 128 * K, K, K, sm, pre,
                 has_next ? Aop + narow * K : nullptr, K, Bop + (size_t)nnt * 128 * K, K);
        pre = has_next;
        gemm_epi<MODE>(p, acc, mt, nt);
      }
    }
  }
  {
    constexpr int NS = (MODE == 11) ? 11 : 8;
    constexpr int KI = K / NS;
    float* skb = p.skacc + (size_t)SkOff<MODE>::v * 16384;
    unsigned* tick = p.sktick + SkOff<MODE>::v;
    unsigned* tkw = (unsigned*)smraw;
    const size_t arow = (size_t)128 * 128;
    constexpr int NH = (MODE == 5) ? 2 : 1;
    for (int it = blockIdx.x; it < NT * NS * NH; it += gridDim.x) {
      const int nt = it % NT, ks = (it / NT) % NS, half = it / (NT * NS);
      int tid2 = threadIdx.x;
      asm volatile("" : "+v"(tid2));
      f32x4 acc[4][4];
      ZERO_ACC(acc);
      const bf16_t* Ah = (MODE == 5 && half) ? p.yb : Aop;
      const bf16_t* Bh = (MODE == 5 && half) ? p.Wt_b : Bop;
      gemm_acc(acc, Ah + arow * K + ks * KI, K, Bh + (size_t)nt * 128 * K + ks * KI, K, KI, sm);
      float* dst = skb + (size_t)nt * 16384 + tid2;
      {
        float* dsth = dst + (size_t)half * 8 * 16384;
#pragma unroll
        for (int ci = 0; ci < 4; ++ci)
#pragma unroll
          for (int ri = 0; ri < 4; ++ri) {
#pragma unroll
            for (int j = 0; j < 4; ++j) atomicAdd(dsth + ((ci * 4 + ri) * 4 + j) * 256, acc[ci][ri][j]);
            asm volatile("" ::: "memory");
          }
      }
      asm volatile("s_waitcnt vmcnt(0)" ::: "memory");
      __syncthreads();
      if (tid == 0) tkw[0] = atomicAdd(tick + nt, 1u);
      __syncthreads();
      const unsigned ticket = tkw[0];
      __syncthreads();
      if (ticket == (unsigned)(NS * NH - 1)) {
        if (MODE == 5) {
          const int row0 = 128 * 128 + wr * 64 + fr;
          const int colb = nt * 128 + wc * 64 + fq * 4;
          const float* src2 = skb + (size_t)(8 + nt) * 16384 + tid2;
#pragma unroll
          for (int ci = 0; ci < 4; ++ci)
#pragma unroll
            for (int ri = 0; ri < 4; ++ri) {
              const size_t off = (size_t)(row0 + ri * 16) * 1024 + colb + ci * 16;
              float ga[4], gb[4], o[4];
              unpack4(*reinterpret_cast<const uint2*>(p.P_ga + off), ga);
              unpack4(*reinterpret_cast<const uint2*>(p.P_gb + off), gb);
#pragma unroll
              for (int j = 0; j < 4; ++j) {
                const float ya = __hip_atomic_load(dst + ((ci * 4 + ri) * 4 + j) * 256, __ATOMIC_RELAXED, __HIP_MEMORY_SCOPE_AGENT);
                const float yb = __hip_atomic_load(src2 + ((ci * 4 + ri) * 4 + j) * 256, __ATOMIC_RELAXED, __HIP_MEMORY_SCOPE_AGENT);
                o[j] = sigmoidf_(ga[j]) * ya + sigmoidf_(gb[j]) * yb;
              }
              *reinterpret_cast<uint2*>(p.merged + off) = pack4(o[0], o[1], o[2], o[3]);
              asm volatile("" ::: "memory");
            }
        } else {
#pragma unroll
          for (int ci = 0; ci < 4; ++ci)
#pragma unroll
            for (int ri = 0; ri < 4; ++ri) {
#pragma unroll
              for (int j = 0; j < 4; ++j)
                acc[ci][ri][j] = __hip_atomic_load(dst + ((ci * 4 + ri) * 4 + j) * 256, __ATOMIC_RELAXED, __HIP_MEMORY_SCOPE_AGENT);
              asm volatile("" ::: "memory");
            }
          gemm_epi<MODE>(p, acc, 128, nt);
        }
      }
    }
  }
}

__device__ __forceinline__ void attn_prompt(const Params& p, int item, unsigned char* smraw) {
  const int tid = threadIdx.x, lane = tid & 63, w = tid >> 6;
  const int fr = lane & 15, fq = lane >> 4;
  const int h = item & 3, rt = (item >> 2) & 31, b = item >> 7;
  bf16_t* KV = (bf16_t*)smraw;
  bf16_t* Ps = KV + 64 * 264 + w * 16 * 264;
  const size_t rowbase = (size_t)b * 2048 + rt * 64 + 16 * w;
  bf16x8 qf[8];
#pragma unroll
  for (int ks = 0; ks < 8; ++ks) qf[ks] = ldfrag(p.q + (rowbase + fr) * 1024 + h * 256 + ks * 32 + fq * 8);
  f32x4 sacc[16];
#pragma unroll
  for (int t = 0; t < 16; ++t) sacc[t] = f32x4{0, 0, 0, 0};
#pragma unroll
  for (int kb = 0; kb < 4; ++kb) {
    __syncthreads();
#pragma unroll
    for (int i = 0; i < 8; ++i) {
      const int id = tid + 256 * i, key = id >> 5, c = id & 31;
      *reinterpret_cast<uint4*>(KV + key * 264 + c * 8) =
          *reinterpret_cast<const uint4*>(p.mkb + ((size_t)b * 256 + kb * 64 + key) * 1024 + h * 256 + c * 8);
    }
    __syncthreads();
#pragma unroll
    for (int ct = 0; ct < 4; ++ct)
#pragma unroll
      for (int ks = 0; ks < 8; ++ks)
        sacc[kb * 4 + ct] = mfma16(ldfrag(KV + (ct * 16 + fr) * 264 + ks * 32 + fq * 8), qf[ks], sacc[kb * 4 + ct]);
  }
  float m = -3.0e38f;
#pragma unroll
  for (int t = 0; t < 16; ++t)
#pragma unroll
    for (int j = 0; j < 4; ++j) m = fmaxf(m, sacc[t][j]);
  m = fmaxf(m, __shfl_xor(m, 16)); m = fmaxf(m, __shfl_xor(m, 32));
  float sum = 0.f;
#pragma unroll
  for (int t = 0; t < 16; ++t)
#pragma unroll
    for (int j = 0; j < 4; ++j) { const float e = __expf(sacc[t][j] - m); sacc[t][j] = e; sum += e; }
  sum += __shfl_xor(sum, 16); sum += __shfl_xor(sum, 32);
  const float inv = 1.f / sum;
#pragma unroll
  for (int t = 0; t < 16; ++t)
    *reinterpret_cast<uint2*>(Ps + fr * 264 + t * 16 + fq * 4) = pack4(sacc[t][0] * inv, sacc[t][1] * inv, sacc[t][2] * inv, sacc[t][3] * inv);
  bf16x8 pf[8];
#pragma unroll
  for (int db = 0; db < 4; ++db) {
    __syncthreads();
#pragma unroll
    for (int i = 0; i < 8; ++i) {
      const int id = tid + 256 * i, dr = id >> 5, c = id & 31;
      *reinterpret_cast<uint4*>(KV + dr * 264 + c * 8) =
          *reinterpret_cast<const uint4*>(p.mvT + ((size_t)(b * 4 + h) * 256 + db * 64 + dr) * 256 + c * 8);
    }
    __syncthreads();
    if (db == 0) {
#pragma unroll
      for (int ks = 0; ks < 8; ++ks) pf[ks] = ldfrag(Ps + fr * 264 + ks * 32 + fq * 8);
    }
    f32x4 oacc[4];
#pragma unroll
    for (int mt = 0; mt < 4; ++mt) {
      oacc[mt] = f32x4{0, 0, 0, 0};
#pragma unroll
      for (int ks = 0; ks < 8; ++ks) oacc[mt] = mfma16(ldfrag(KV + (mt * 16 + fr) * 264 + ks * 32 + fq * 8), pf[ks], oacc[mt]);
      *reinterpret_cast<uint2*>(p.ao + (rowbase + fr) * 1024 + h * 256 + db * 64 + mt * 16 + fq * 4) =
          pack4(oacc[mt][0], oacc[mt][1], oacc[mt][2], oacc[mt][3]);
    }
  }
  __syncthreads();
}

__device__ __forceinline__ void attn_sample(const Params& p, int item, unsigned char* smraw) {
  const int tid = threadIdx.x, lane = tid & 63, w = tid >> 6;
  const int b = item >> 2, h = item & 3;
  const size_t row = NPR + b;
  float* sc = (float*)smraw;
  float* red = sc + 256;
  float q4[4];
  unpack4(*reinterpret_cast<const uint2*>(p.q + row * 1024 + h * 256 + lane * 4), q4);
  const float* Kc = p.cache_k + ((size_t)b * 256 * 4 + h) * 256 + lane * 4;
#pragma unroll 16
  for (int i = 0; i < 64; ++i) {
    const int m = w * 64 + i;
    const float4 kv = ldnt4(Kc + (size_t)m * 1024);
    float d = kv.x * q4[0] + kv.y * q4[1] + kv.z * q4[2] + kv.w * q4[3];
    d = wave_sum(d);
    if (lane == 0) sc[m] = d;
  }
  __syncthreads();
  const float s = sc[tid];
  float mx = s;
  for (int o = 32; o > 0; o >>= 1) mx = fmaxf(mx, __shfl_xor(mx, o));
  if (lane == 0) red[w] = mx;
  __syncthreads();
  mx = fmaxf(fmaxf(red[0], red[1]), fmaxf(red[2], red[3]));
  const float e = __expf(s - mx);
  const float sm_ = wave_sum(e);
  if (lane == 0) red[4 + w] = sm_;
  __syncthreads();
  const float tot = (red[4] + red[5]) + (red[6] + red[7]);
  sc[tid] = e / tot;
  __syncthreads();
  {
    float* part = red + 8;
    const int dq = lane * 4, kg = w;
    const float* Vc = p.cache_v + (((size_t)b * 256 + kg * 64) * 4 + h) * 256 + dq;
    float o0 = 0.f, o1 = 0.f, o2 = 0.f, o3 = 0.f;
#pragma unroll 16
    for (int m = 0; m < 64; ++m) {
      const float4 v = ldnt4(Vc + (size_t)m * 1024);
      const float pm = sc[kg * 64 + m];
      o0 += pm * v.x; o1 += pm * v.y; o2 += pm * v.z; o3 += pm * v.w;
    }
    *reinterpret_cast<float4*>(part + kg * 256 + dq) = make_float4(o0, o1, o2, o3);
    __syncthreads();
    p.ao[row * 1024 + h * 256 + tid] = f2bf((part[tid] + part[256 + tid]) + (part[512 + tid] + part[768 + tid]));
  }
  __syncthreads();
}

__device__ __forceinline__ void phase8(const Params& p, unsigned char* smraw) {
  const int G = gridDim.x;
  const bool sample_first = (blockIdx.x & 256) != 0;
  if (sample_first) for (int it = first_item(1024); it < 1536; it += G) attn_sample(p, it - 1024, smraw);
  for (int it = first_item(0); it < 1024; it += G) attn_prompt(p, it, smraw);
  if (!sample_first) for (int it = first_item(1024); it < 1536; it += G) attn_sample(p, it - 1024, smraw);
}

__device__ __forceinline__ void phase12(const Params& p) {
  const int tid = threadIdx.x, lane = tid & 63, wid = tid >> 6;
  for (int r = blockIdx.x * 4 + wid; r < NTOK; r += gridDim.x * 4) {
    const float rs = row_rs(p.ss3, r);
    float* o = p.out + (size_t)r * 1024;
#pragma unroll
    for (int i = 0; i < 4; ++i) {
      float4 v = *reinterpret_cast<const float4*>(o + i * 256 + lane * 4);
      const float4 g = *reinterpret_cast<const float4*>(p.norm_final_g + i * 256 + lane * 4);
      v.x *= rs * g.x; v.y *= rs * g.y; v.z *= rs * g.z; v.w *= rs * g.w;
      *reinterpret_cast<float4*>(o + i * 256 + lane * 4) = v;
    }
  }
}


#define XB_TMO      128
#define XB_XCNT(j)  (256  + 64 * (j))
#define XB_XSUB(j)  (1280 + 64 * (j))
#define XB_XGEN(j)  (2304 + 64 * (j))
#define XB_TOP      3328
#define XB_TOPGEN   3392
#define XCD_BAR_WORDS 3456
#define XB_SPIN_CAP (1u << 22)
#define LAS __attribute__((address_space(3)))
__device__ __forceinline__ unsigned xb_ld(unsigned* p) { return __hip_atomic_load(p, __ATOMIC_RELAXED, __HIP_MEMORY_SCOPE_AGENT); }
__device__ __forceinline__ unsigned xb_add(unsigned* p, unsigned v) { return __hip_atomic_fetch_add(p, v, __ATOMIC_RELAXED, __HIP_MEMORY_SCOPE_AGENT); }
__device__ __forceinline__ unsigned xb_xcc_id() { return (unsigned)__builtin_amdgcn_s_getreg((3 << 11) | 20) & 0xFu; }
#define XB_SPIN(cond, bar) do { unsigned _sp = 0; while (cond) { __builtin_amdgcn_s_sleep(1); \
    if ((++_sp & 255u) == 0u) { if (xb_ld(&(bar)[XB_TMO])) break; if (_sp > XB_SPIN_CAP) { atomicAdd(&(bar)[XB_TMO], 1u); break; } } } } while (0)
struct XcdBarrier { unsigned* bar; unsigned x; volatile LAS unsigned* st; };
__device__ __forceinline__ XcdBarrier xcd_barrier_post(unsigned* bar, volatile LAS unsigned* st) {
  XcdBarrier b; b.bar = bar; b.x = xb_xcc_id(); b.st = st;
  if (threadIdx.x == 0) (void)xb_add(&bar[XB_XCNT(b.x)], 1u);
  return b;
}
__device__ __forceinline__ void xcd_barrier_complete(unsigned* bar, unsigned x, unsigned& nloc, unsigned& nx) {
  const unsigned G = gridDim.x * gridDim.y * gridDim.z;
  unsigned sum, cnt, mine, sp = 0u;
  for (;;) {
    sum = 0u; cnt = 0u; mine = 0u;
#pragma unroll
    for (unsigned j = 0; j < 16; ++j) { const unsigned c = xb_ld(&bar[XB_XCNT(j)]); sum += c; cnt += (c > 0u) ? 1u : 0u; mine = (j == x) ? c : mine; }
    if (sum == G) break;
    __builtin_amdgcn_s_sleep(1);
    if ((++sp & 255u) == 0u) { if (xb_ld(&bar[XB_TMO])) break; if (sp > XB_SPIN_CAP) { atomicAdd(&bar[XB_TMO], 1u); break; } }
  }
  nloc = mine > 0u ? mine : 1u; nx = cnt > 0u ? cnt : 1u;
}
__device__ __forceinline__ void xcd_barrier(const XcdBarrier& b) {
  asm volatile("s_waitcnt vmcnt(0)" ::: "memory");
  __syncthreads();
  if (threadIdx.x == 0) {
    unsigned* bar = b.bar;
    __builtin_amdgcn_s_waitcnt(0);
    unsigned nloc = b.st[0], nx = b.st[1];
    if (nloc == 0u) { xcd_barrier_complete(bar, b.x, nloc, nx); b.st[0] = nloc; b.st[1] = nx; }
    const unsigned old = xb_add(&bar[XB_XSUB(b.x)], 1u);
    const unsigned gen = old / nloc;
    if (old + 1u == (gen + 1u) * nloc) {
      __builtin_amdgcn_fence(__ATOMIC_RELEASE, "agent");
      asm volatile("s_waitcnt vmcnt(0)" ::: "memory");
      const unsigned og = xb_add(&bar[XB_TOP], 1u);
      const unsigned tg = og / nx;
      if (og + 1u == (tg + 1u) * nx) xb_add(&bar[XB_TOPGEN], 1u);
      else XB_SPIN(xb_ld(&bar[XB_TOPGEN]) == tg, bar);
      __builtin_amdgcn_fence(__ATOMIC_ACQUIRE, "agent");
      xb_add(&bar[XB_XGEN(b.x)], 1u);
      asm volatile("s_waitcnt vmcnt(0)" ::: "memory");
    } else {
      XB_SPIN(xb_ld(&bar[XB_XGEN(b.x)]) == gen, bar);
      __builtin_amdgcn_fence(__ATOMIC_ACQUIRE, "agent");
      asm volatile("s_waitcnt vmcnt(0)" ::: "memory");
    }
  }
  __syncthreads();
}

__global__ void __launch_bounds__(256, 2) mega(Params p, int ph_lo, int ph_hi) {
  __shared__ __attribute__((aligned(16))) unsigned char smem[SMEM_BYTES];
  __shared__ uint4 xb_words;
  cg::grid_group grid = cg::this_grid();
  if (ph_lo > 1000) grid.sync();
  if (threadIdx.x == 0) xb_words = make_uint4(0u, 0u, 0u, 0u);
  __syncthreads();
  XcdBarrier xb = xcd_barrier_post(p.bar, (volatile LAS unsigned*)&xb_words);
#ifdef ONLY_PHASE
#define RUNPH(PH, CALL) if (PH == ONLY_PHASE && ph_lo <= PH && PH < ph_hi) { if (PH > ph_lo) xcd_barrier(xb); CALL; }
#else
#define RUNPH(PH, CALL) if (ph_lo <= PH && PH < ph_hi) { if (PH > ph_lo) xcd_barrier(xb); CALL; }
#endif
  RUNPH(0, phase0(p, smem))
  RUNPH(1, phase1(p, smem))
  RUNPH(2, phase2(p, smem))
  RUNPH(3, phase3(p, smem))
  RUNPH(4, phase4(p))
  RUNPH(5, gemm_phase<5>(p, smem))
  RUNPH(6, gemm_phase<6>(p, smem))
  RUNPH(7, gemm_phase<7>(p, smem))
  RUNPH(8, phase8(p, smem))
  RUNPH(9, gemm_phase<9>(p, smem))
  RUNPH(10, gemm_phase<10>(p, smem))
  RUNPH(11, gemm_phase<11>(p, smem))
  RUNPH(12, phase12(p))
}

static inline size_t al256(size_t x) { return (x + 255) & ~(size_t)255; }

extern "C" void kernel_launch(void* const* d_in, const int* in_sizes, int n_in, void* d_out, int out_size, void* d_ws,
                              size_t ws_size, hipStream_t stream) {
  static int grid_blocks = 0;
  if (!grid_blocks) {
    int dev = 0, cus = 0, per_cu = 0;
    hipGetDevice(&dev);
    hipDeviceGetAttribute(&cus, hipDeviceAttributeMultiprocessorCount, dev);
    hipOccupancyMaxActiveBlocksPerMultiprocessor(&per_cu, mega, 256, 0);
    if (per_cu > 2) per_cu = 2;
    if (per_cu < 1) per_cu = 1;
    grid_blocks = cus * per_cu;
  }
  Params p{};
  const float* const* in = (const float* const*)d_in;
  p.x_prompt = in[0]; p.x_sample = in[1]; p.state_ret = in[2]; p.state_gdn = in[3]; p.state_conv = in[4];
  p.cache_k = in[5]; p.cache_v = in[6]; p.mem_prompt = in[7];
  p.norm_mix_g = in[8]; p.w_in = in[9]; p.ret_gn_g = in[10]; p.w_a = in[11]; p.conv_w = in[12]; p.a_log = in[13];
  p.dt_bias = in[14]; p.gdn_norm_g = in[15]; p.w_b = in[16]; p.w_out = in[17]; p.norm_x_g = in[18]; p.mem_norm_g = in[19];
  p.w_xq = in[20]; p.w_xk = in[21]; p.w_xv = in[22]; p.w_xo = in[23]; p.norm_ffn_g = in[24]; p.w_gate = in[25];
  p.w_up = in[26]; p.w_down = in[27]; p.norm_final_g = in[28];
  p.out = (float*)d_out;

  unsigned char* ws = (unsigned char*)d_ws;
  size_t off = 0;
  auto take = [&](size_t bytes) { unsigned char* r = ws + off; off = al256(off + bytes); return r; };
  const size_t ACT = (size_t)NTOK * 1024 * 2;
  p.Wt_in = (bf16_t*)take((size_t)9344 * 1024 * 2);
  p.Wt_a = (bf16_t*)take((size_t)1024 * 1024 * 2);
  p.Wt_b = (bf16_t*)take((size_t)1024 * 1024 * 2);
  p.Wt_out = (bf16_t*)take((size_t)1024 * 1024 * 2);
  p.Wt_xq = (bf16_t*)take((size_t)1024 * 1024 * 2);
  p.Wt_kv = (bf16_t*)take((size_t)2048 * 1024 * 2);
  p.Wt_xo = (bf16_t*)take((size_t)1024 * 1024 * 2);
  p.Wt_gu = (bf16_t*)take((size_t)5632 * 1024 * 2);
  p.Wt_down = (bf16_t*)take((size_t)1024 * 2816 * 2);
  {
    unsigned char* rh = take((size_t)1024 * 40960);
    p.h = (bf16_t*)rh;
    p.r_QD = (bf16_t*)rh;
    p.r_KDT = (bf16_t*)(rh + (size_t)1024 * 16384);
    p.r_SC = (bf16_t*)(rh + (size_t)1024 * 32768);
  }
  p.P_rqk = (bf16_t*)take(ACT);
  p.P_rv = (bf16_t*)take(ACT);
  p.P_rg = (bf16_t*)take(ACT);
  p.P_qkv = (bf16_t*)take(ACT * 3);
  p.P_z = (bf16_t*)take(ACT);
  p.P_ga = (bf16_t*)take(ACT);
  p.P_gb = (bf16_t*)take(ACT);
  {
    unsigned char* rg = take((size_t)2048 * 73728);
    p.g_W = (bf16_t*)rg;
    p.g_QH = (bf16_t*)(rg + (size_t)2048 * 16384);
    p.g_KT = (bf16_t*)(rg + (size_t)2048 * 32768);
    p.g_U = (bf16_t*)(rg + (size_t)2048 * 49152);
    p.g_QK = (bf16_t*)(rg + (size_t)2048 * 65536);
    p.ya = (bf16_t*)rg;
    p.yb = (bf16_t*)(rg + ACT);
  }
  p.g_GS = (float*)take((size_t)2048 * 128 * 4);
  p.mn = (bf16_t*)take((size_t)2048 * 1024 * 2);
  p.ropec = (float*)take((size_t)2049 * 64 * 4);
  p.ropes = (float*)take((size_t)2049 * 64 * 4);
  p.beta = (float*)take((size_t)NTOK * 8 * 4);
  p.gl = (float*)take((size_t)NTOK * 8 * 4);
  p.mkb = (bf16_t*)take((size_t)2048 * 1024 * 2);
  p.mvT = (bf16_t*)take((size_t)2048 * 1024 * 2);
  p.ss1 = (float*)take((size_t)NTOK * 16 * 4);
  p.ss2 = (float*)take((size_t)NTOK * 16 * 4);
  p.ss3 = (float*)take((size_t)NTOK * 16 * 4);
  p.bar = (unsigned*)take((size_t)XCD_BAR_WORDS * 4);
  p.skacc = (float*)take((size_t)92 * 16384 * 4);
  p.sktick = (unsigned*)take((size_t)128 * 4);
  p.o_r = p.P_qkv;
  p.o_g = (bf16_t*)((unsigned char*)p.P_qkv + ACT);
  p.merged = p.P_rqk;
  p.x1b = p.P_rv;
  p.q = p.P_rg;
  p.ao = p.P_z;
  p.x2b = p.P_ga;
  p.ff = p.P_qkv;
  if (off > ws_size) {
    fprintf(stderr, "kernel_launch: workspace too small: need %zu have %zu\n", off, ws_size);
    return;
  }
  int t0 = 0;
  auto job = [&](int i, const float* s0, const float* s1, const float* gf, bf16_t* dst, int ld, int K, int Nd, int mode, float scale) {
    p.jobs[i].src0 = s0; p.jobs[i].src1 = s1; p.jobs[i].gfold = gf; p.jobs[i].dst = dst; p.jobs[i].ld_src = ld;
    p.jobs[i].K = K; p.jobs[i].Nd = Nd; p.jobs[i].mode = mode; p.jobs[i].scale = scale; p.jobs[i].tile0 = t0;
    t0 += (Nd / 64) * (K / 256);
  };
  job(0, p.w_in, nullptr, p.norm_mix_g, p.Wt_in, 9232, 1024, 9344, 1, 1.f);
  job(1, p.w_a, nullptr, nullptr, p.Wt_a, 1024, 1024, 1024, 0, 1.f);
  job(2, p.w_b, nullptr, nullptr, p.Wt_b, 1024, 1024, 1024, 0, 1.f);
  job(3, p.w_out, nullptr, nullptr, p.Wt_out, 1024, 1024, 1024, 0, 1.f);
  job(4, p.w_xq, nullptr, p.norm_x_g, p.Wt_xq, 1024, 1024, 1024, 0, 0.0625f);
  job(5, p.w_xk, p.w_xv, p.mem_norm_g, p.Wt_kv, 1024, 1024, 2048, 3, 1.f);
  job(6, p.w_xo, nullptr, nullptr, p.Wt_xo, 1024, 1024, 1024, 0, 1.f);
  job(7, p.w_gate, p.w_up, p.norm_ffn_g, p.Wt_gu, 2816, 1024, 5632, 2, 1.f);
  job(8, p.w_down, nullptr, nullptr, p.Wt_down, 1024, 2816, 1024, 0, 1.f);
  p.n_wtiles = t0;

#ifdef MULTI_LAUNCH
  for (int ph = 0; ph < NPHASE; ++ph) {
    hipLaunchKernelGGL(mega, dim3(grid_blocks), dim3(256), 0, stream, p, ph, ph + 1);
  }
#else
  hipMemsetAsync(p.bar, 0, (size_t)XCD_BAR_WORDS * 4, stream);
  int lo = 0, hi = NPHASE;
  void* args[] = {&p, &lo, &hi};
  hipError_t e = hipLaunchCooperativeKernel((void*)mega, dim3(grid_blocks), dim3(256), args, 0, stream);
  if (e != hipSuccess) fprintf(stderr, "cooperative launch failed: %s (grid %d)\n", hipGetErrorString(e), grid_blocks);
#endif
}
```

```cpp
#include <hip/hip_runtime.h>
#include <hip/hip_cooperative_groups.h>
#include <stdint.h>
#include <math.h>
#include <cstdio>
namespace cg = cooperative_groups;

typedef unsigned short bf16_t;
using bf16x8 = __attribute__((ext_vector_type(8))) short;
using f32x4 = __attribute__((ext_vector_type(4))) float;

#define NTOK 16512
#define NPR 16384
#define EPSF 1e-6f
#define NPHASE 13
#define SMEM_BYTES 73728

struct ConvJob {
  const float* src0; const float* src1; const float* gfold; bf16_t* dst;
  int ld_src; int K; int Nd; int mode; float scale; int tile0;
};

struct Params {
  const float *x_prompt, *x_sample, *state_ret, *state_gdn, *state_conv, *cache_k, *cache_v, *mem_prompt;
  const float *norm_mix_g, *w_in, *ret_gn_g, *w_a, *conv_w, *a_log, *dt_bias, *gdn_norm_g, *w_b, *w_out;
  const float *norm_x_g, *mem_norm_g, *w_xq, *w_xk, *w_xv, *w_xo, *norm_ffn_g, *w_gate, *w_up, *w_down, *norm_final_g;
  float* out;
  bf16_t *Wt_in, *Wt_a, *Wt_b, *Wt_out, *Wt_xq, *Wt_kv, *Wt_xo, *Wt_gu, *Wt_down;
  bf16_t *h, *mn; float *ropec, *ropes;
  bf16_t *P_rqk, *P_rv, *P_rg, *P_qkv, *P_z, *P_ga, *P_gb;
  float *beta, *gl;
  bf16_t *mkb, *mvT;
  bf16_t *g_W, *g_QH, *g_KT, *g_QK, *g_U; float* g_GS;
  bf16_t *r_QD, *r_KDT, *r_SC;
  bf16_t *o_r, *o_g, *ya, *yb, *merged, *x1b, *q, *ao, *x2b, *ff;
  float *ss1, *ss2, *ss3;
  unsigned* bar;
  float* skacc; unsigned* sktick;
  ConvJob jobs[9];
  int n_wtiles; int pad0;
};

__device__ const double c_inv_rev[64] = {
  0.15915494309189535, 0.13782250260398285, 0.11934937021124886, 0.10335229661843406,
  0.08949940160889101, 0.07750328875537406, 0.06711508300522726, 0.058119267441876246,
  0.050329212104487035, 0.04358330210530733, 0.03774158471741977, 0.032682865872357,
  0.0283021958306234, 0.024508691862069852, 0.02122365276477766, 0.018378926105679667,
  0.015915494309189534, 0.013782250260398284, 0.011934937021124886, 0.010335229661843406,
  0.008949940160889102, 0.0077503288755374055, 0.006711508300522725, 0.005811926744187624,
  0.005032921210448704, 0.004358330210530733, 0.003774158471741977, 0.0032682865872356993,
  0.00283021958306234, 0.002450869186206985, 0.0021223652764777662, 0.0018378926105679667,
  0.0015915494309189536, 0.0013782250260398288, 0.0011934937021124885, 0.0010335229661843405,
  0.0008949940160889102, 0.0007750328875537405, 0.0006711508300522726, 0.0005811926744187624,
  0.0005032921210448703, 0.0004358330210530733, 0.00037741584717419774, 0.0003268286587235699,
  0.00028302195830623395, 0.00024508691862069854, 0.0002122365276477766, 0.00018378926105679666,
  0.00015915494309189535, 0.00013782250260398286, 0.00011934937021124886, 0.00010335229661843406,
  8.949940160889102e-05, 7.750328875537406e-05, 6.711508300522725e-05, 5.811926744187624e-05,
  5.0329212104487035e-05, 4.358330210530732e-05, 3.774158471741978e-05, 3.2682865872357e-05,
  2.8302195830623396e-05, 2.4508691862069852e-05, 2.122365276477766e-05, 1.8378926105679668e-05,
};

#define OUT_Y 0
#define OUT_SR_P 16908288
#define OUT_SG_P 17956864
#define OUT_SC_P 19005440
#define OUT_MK_P 19079168
#define OUT_MV_P 21176320
#define OUT_SR_S 23273472
#define OUT_SG_S 40050688
#define OUT_SC_S 56827904

__device__ __forceinline__ unsigned short f2bf(float f) {
  unsigned u = __float_as_uint(f);
  u += 0x7fffu + ((u >> 16) & 1u);
  return (unsigned short)(u >> 16);
}
__device__ __forceinline__ float bf2f(unsigned short b) { return __uint_as_float(((unsigned)b) << 16); }
__device__ __forceinline__ unsigned pack2(float a, float b) { return (unsigned)f2bf(a) | ((unsigned)f2bf(b) << 16); }
__device__ __forceinline__ uint2 pack4(float a, float b, float c, float d) { return make_uint2(pack2(a, b), pack2(c, d)); }
__device__ __forceinline__ uint4 pack8(const float* v) {
  return make_uint4(pack2(v[0], v[1]), pack2(v[2], v[3]), pack2(v[4], v[5]), pack2(v[6], v[7]));
}
__device__ __forceinline__ void unpack8(uint4 r, float* v) {
  v[0] = __uint_as_float(r.x << 16); v[1] = __uint_as_float(r.x & 0xffff0000u);
  v[2] = __uint_as_float(r.y << 16); v[3] = __uint_as_float(r.y & 0xffff0000u);
  v[4] = __uint_as_float(r.z << 16); v[5] = __uint_as_float(r.z & 0xffff0000u);
  v[6] = __uint_as_float(r.w << 16); v[7] = __uint_as_float(r.w & 0xffff0000u);
}
__device__ __forceinline__ void unpack4(uint2 r, float* v) {
  v[0] = __uint_as_float(r.x << 16); v[1] = __uint_as_float(r.x & 0xffff0000u);
  v[2] = __uint_as_float(r.y << 16); v[3] = __uint_as_float(r.y & 0xffff0000u);
}
__device__ __forceinline__ f32x4 mfma16(bf16x8 a, bf16x8 b, f32x4 c) {
  return __builtin_amdgcn_mfma_f32_16x16x32_bf16(a, b, c, 0, 0, 0);
}
__device__ __forceinline__ bf16x8 ldfrag(const bf16_t* p) { return *reinterpret_cast<const bf16x8*>(p); }
__device__ __forceinline__ float4 ldnt4(const float* p) {
  const f32x4 v = __builtin_nontemporal_load(reinterpret_cast<const f32x4*>(p));
  return make_float4(v[0], v[1], v[2], v[3]);
}
__device__ __forceinline__ void stnt4(float* p, float4 v) {
  f32x4 t = {v.x, v.y, v.z, v.w};
  __builtin_nontemporal_store(t, reinterpret_cast<f32x4*>(p));
}
__device__ __forceinline__ float sigmoidf_(float x) { return 1.f / (1.f + __expf(-x)); }
__device__ __forceinline__ float siluf_(float x) { return x / (1.f + __expf(-x)); }
__device__ __forceinline__ float wave_sum(float v) {
  for (int o = 32; o > 0; o >>= 1) v += __shfl_xor(v, o);
  return v;
}

#define LROW 72
__device__ __forceinline__ void gemm_acc(f32x4 (&acc)[4][4], const bf16_t* __restrict__ A, int lda,
                                         const bf16_t* __restrict__ Bt, int ldb, int K, bf16_t* sm,
                                         bool pre = false, const bf16_t* nA = nullptr, int nlda = 0,
                                         const bf16_t* nB = nullptr, int nldb = 0) {
  const int tid = threadIdx.x, lane = tid & 63, wid = tid >> 6;
  const int wr = wid >> 1, wc = wid & 1, fr = lane & 15, fq = lane >> 4;
  unsigned char* smb = (unsigned char*)sm;
  const int nk = K >> 6;
  const int drow = lane >> 3, dpos = lane & 7;
  const bf16_t* Asrc[4]; const bf16_t* Bsrc[4];
#pragma unroll
  for (int j = 0; j < 4; ++j) {
    const int r = (wid * 4 + j) * 8 + drow;
    const int c = dpos ^ ((r >> 1) & 7);
    Asrc[j] = A + (size_t)r * lda + c * 8;
    Bsrc[j] = Bt + (size_t)r * ldb + c * 8;
  }
  const unsigned lds_base = (unsigned)(size_t)(__attribute__((address_space(3))) unsigned char*)smb;
  const unsigned lds_w = __builtin_amdgcn_readfirstlane(lds_base + wid * 4096);
#define GLDS16(gsrc, ldsaddr) do { unsigned _keep; const unsigned _la = (ldsaddr);                                      \
    asm volatile("s_mov_b32 %0, m0\n\ts_mov_b32 m0, %2\n\ts_nop 0\n\tglobal_load_lds_dwordx4 %1, off\n\ts_mov_b32 m0, %0" \
                 : "=&s"(_keep) : "v"(gsrc), "s"(_la) : "memory"); } while (0)
#define GEMM_ISSUE(stage, k0)                                                                                           \
  _Pragma("unroll") for (int j = 0; j < 4; ++j) {                                                                      \
    GLDS16(Asrc[j] + (k0), lds_w + (stage) * 32768 + j * 1024);                                                        \
    GLDS16(Bsrc[j] + (k0), lds_w + (stage) * 32768 + 16384 + j * 1024);                                                \
  }
  if (!pre) {
    asm volatile("s_waitcnt vmcnt(0)" ::: "memory");
    GEMM_ISSUE(0, 0)
  }
  const int rdA = (wr * 64 + fr) * 128, rdB = 16384 + (wc * 64 + fr) * 128;
  const int sw = fr >> 1;
  for (int kt = 0; kt < nk; ++kt) {
    const int cur = kt & 1;
    asm volatile("s_waitcnt vmcnt(0)" ::: "memory");
    asm volatile("s_waitcnt lgkmcnt(0)" ::: "memory");
    __builtin_amdgcn_s_barrier();
    if (kt + 1 < nk) {
      if (cur) { GEMM_ISSUE(0, (kt + 1) * 64) } else { GEMM_ISSUE(1, (kt + 1) * 64) }
    } else if (nA != nullptr) {
#pragma unroll
      for (int j = 0; j < 4; ++j) {
        const int r = (wid * 4 + j) * 8 + drow;
        const int c = dpos ^ ((r >> 1) & 7);
        GLDS16(nA + (size_t)r * nlda + c * 8, lds_w + j * 1024);
        GLDS16(nB + (size_t)r * nldb + c * 8, lds_w + 16384 + j * 1024);
      }
    }
    const unsigned char* cA = smb + cur * 32768 + rdA;
    const unsigned char* cB = smb + cur * 32768 + rdB;
#pragma unroll
    for (int kk = 0; kk < 2; ++kk) {
      bf16x8 af[4], bfr[4];
      const int co = ((kk * 4 + fq) ^ sw) * 16;
#pragma unroll
      for (int i = 0; i < 4; ++i) {
        af[i] = *reinterpret_cast<const bf16x8*>(cA + i * 2048 + co);
        bfr[i] = *reinterpret_cast<const bf16x8*>(cB + i * 2048 + co);
      }
      __builtin_amdgcn_s_setprio(1);
#pragma unroll
      for (int ci = 0; ci < 4; ++ci)
#pragma unroll
        for (int ri = 0; ri < 4; ++ri) acc[ci][ri] = mfma16(bfr[ci], af[ri], acc[ci][ri]);
      __builtin_amdgcn_s_setprio(0);
    }
  }
  __syncthreads();
#undef GEMM_ISSUE
#undef GLDS16
}

__device__ __forceinline__ int first_item(int lo) {
  const int G = gridDim.x;
  int r = ((int)blockIdx.x - lo) % G; if (r < 0) r += G;
  return lo + r;
}
__device__ __forceinline__ void tile_range(int T, int& t0, int& t1, int& step) {
  const int G = gridDim.x;
  if (G & 7) { t0 = blockIdx.x; t1 = T; step = G; return; }
  const int x = blockIdx.x & 7, l = blockIdx.x >> 3;
  t0 = (int)(((long)x * T) >> 3) + l; t1 = (int)(((long)(x + 1) * T) >> 3); step = G >> 3;
}
__device__ __forceinline__ void tile_decode(int t, int MT, int NT, int& mt, int& nt) {
  const int ng = NT >> 3, gs = MT * 8;
  if (t < ng * gs) { const int g = t / gs, r = t - g * gs; mt = r >> 3; nt = g * 8 + (r & 7); }
  else { const int rem = NT & 7; const int r = t - ng * gs; mt = r / rem; nt = ng * 8 + r % rem; }
}
#define ZERO_ACC(acc) _Pragma("unroll") for (int _a = 0; _a < 4; ++_a) _Pragma("unroll") for (int _b = 0; _b < 4; ++_b) acc[_a][_b] = f32x4{0.f, 0.f, 0.f, 0.f};

__device__ __forceinline__ void phase0(const Params& p, unsigned char* smraw) {
  const int tid = threadIdx.x, lane = tid & 63, wid = tid >> 6;
  const int G = gridDim.x;
  for (int it = first_item(0); it < p.n_wtiles; it += G) {
    struct { const float* src0; const float* src1; const float* gfold; bf16_t* dst; int ld_src, K, Nd, mode; float scale; int tile0; } jb;
#define JSEL(F) jb.F = p.jobs[0].F; _Pragma("unroll") for (int q = 1; q < 9; ++q) if (it >= p.jobs[q].tile0) jb.F = p.jobs[q].F;
    JSEL(src0) JSEL(src1) JSEL(gfold) JSEL(dst) JSEL(ld_src) JSEL(K) JSEL(Nd) JSEL(mode) JSEL(scale) JSEL(tile0)
#undef JSEL
    const int tl = it - jb.tile0;
    const int nRt = jb.Nd >> 6;
    const int R = (tl % nRt) * 64 + lane, k0 = (tl / nRt) * 256 + wid * 64;
    const float* src = jb.src0; int col = R; bool valid = true;
    if (jb.mode == 1) {
      if (R < 7168) col = R; else if (R < 9216) col = R + 16; else if (R < 9232) col = 7168 + (R - 9216); else valid = false;
    } else if (jb.mode == 2) {
      col = R >> 1; if (R & 1) src = jb.src1;
    } else if (jb.mode == 3) {
      if (R >= 1024) { src = jb.src1; col = R - 1024; }
    }
    const float* sp = src + (size_t)k0 * jb.ld_src + col;
    bf16_t* dp = jb.dst + (size_t)R * jb.K + k0;
    const float* gf = jb.gfold;
    const float scale = jb.scale;
#pragma unroll 2
    for (int kb = 0; kb < 64; kb += 32) {
      float v[32];
#pragma unroll
      for (int i = 0; i < 32; ++i) v[i] = valid ? __builtin_nontemporal_load(sp + (size_t)(kb + i) * jb.ld_src) : 0.f;
#pragma unroll
      for (int i = 0; i < 32; ++i) { v[i] *= scale; if (gf) v[i] *= gf[k0 + kb + i]; }
#pragma unroll
      for (int i = 0; i < 32; i += 8) *reinterpret_cast<uint4*>(dp + kb + i) = pack8(v + i);
    }
  }
  const int n_rowitems = (NTOK + 2048) / 8;
  for (int it = first_item(p.n_wtiles); it < p.n_wtiles + n_rowitems; it += G) {
    const int rbase = (it - p.n_wtiles) * 8 + wid * 2;
    const float* src[2]; bf16_t* dst[2];
#pragma unroll
    for (int q = 0; q < 2; ++q) {
      const int r = rbase + q;
      if (r < NPR) { src[q] = p.x_prompt + (size_t)r * 1024; dst[q] = p.h + (size_t)r * 1024; }
      else if (r < NTOK) { src[q] = p.x_sample + (size_t)(r - NPR) * 1024; dst[q] = p.h + (size_t)r * 1024; }
      else { src[q] = p.mem_prompt + (size_t)(r - NTOK) * 1024; dst[q] = p.mn + (size_t)(r - NTOK) * 1024; }
    }
    float4 v[2][4];
#pragma unroll
    for (int q = 0; q < 2; ++q)
#pragma unroll
      for (int i = 0; i < 4; ++i) v[q][i] = ldnt4(src[q] + i * 256 + lane * 4);
#pragma unroll
    for (int q = 0; q < 2; ++q) {
      float ss = 0.f;
#pragma unroll
      for (int i = 0; i < 4; ++i) ss += v[q][i].x * v[q][i].x + v[q][i].y * v[q][i].y + v[q][i].z * v[q][i].z + v[q][i].w * v[q][i].w;
      ss = wave_sum(ss);
      const float rs = rsqrtf(ss * (1.f / 1024.f) + EPSF);
#pragma unroll
      for (int i = 0; i < 4; ++i)
        *reinterpret_cast<uint2*>(dst[q] + i * 256 + lane * 4) = pack4(v[q][i].x * rs, v[q][i].y * rs, v[q][i].z * rs, v[q][i].w * rs);
    }
  }
  const int n_rope = (2049 * 64 + 255) / 256;
  for (int it = first_item(p.n_wtiles + n_rowitems); it < p.n_wtiles + n_rowitems + n_rope; it += G) {
    const int e = (it - p.n_wtiles - n_rowitems) * 256 + tid;
    if (e < 2049 * 64) {
      const int pr = e >> 6, i = e & 63;
      const double pos = (pr == 2048) ? 16384.0 : (double)pr;
      double rev = pos * c_inv_rev[i];
      rev = rev - floor(rev);
      const float fr_ = (float)rev;
      p.ropec[e] = __builtin_amdgcn_cosf(fr_);
      p.ropes[e] = __builtin_amdgcn_sinf(fr_);
    }
  }
  for (int i = blockIdx.x * 256 + tid; i < 92 * 16384 / 4; i += G * 256)
    reinterpret_cast<float4*>(p.skacc)[i] = make_float4(0.f, 0.f, 0.f, 0.f);
  if (blockIdx.x == 0 && tid < 128) p.sktick[tid] = 0u;
}

__device__ __forceinline__ void phase1(const Params& p, unsigned char* smraw) {
  const int tid = threadIdx.x, lane = tid & 63, wid = tid >> 6;
  const int wr = wid >> 1, wc = wid & 1, fr = lane & 15, fq = lane >> 4;
  bf16_t* sm = (bf16_t*)smraw;
  const int nMain = 129 * 72;
  const int total = nMain + 129 + 256;
  int t0, t1, tstep;
  tile_range(nMain, t0, t1, tstep);
  auto tile_ops = [&](int t, const bf16_t*& A, const bf16_t*& B) __attribute__((always_inline)) {
    if (t < nMain + 129) {
      int mt, nt;
      if (t < nMain) tile_decode(t, 129, 72, mt, nt); else { mt = t - nMain; nt = 72; }
      A = p.h + (size_t)mt * 128 * 1024; B = p.Wt_in + (size_t)nt * 128 * 1024;
    } else {
      const int t2 = t - nMain - 129;
      A = p.mn + (size_t)(t2 >> 4) * 128 * 1024; B = p.Wt_kv + (size_t)(t2 & 15) * 128 * 1024;
    }
  };
  bool pre = false;
  for (int t = t0;; t += tstep) {
    if (t >= t1) {
      if (t1 < nMain + 1) { t = nMain + blockIdx.x; t1 = total; tstep = gridDim.x; }
      if (t >= t1) break;
    }
    int tn = t + tstep;
    if (tn >= t1) { if (t1 < nMain + 1) { tn = nMain + blockIdx.x; if (tn >= total) tn = -1; } else tn = -1; }
    const bf16_t *nA = nullptr, *nB = nullptr;
    if (tn >= 0) tile_ops(tn, nA, nB);
    f32x4 acc[4][4];
    ZERO_ACC(acc);
    if (t < nMain + 129) {
      int mt, nt;
      if (t < nMain) tile_decode(t, 129, 72, mt, nt); else { mt = t - nMain; nt = 72; }
      gemm_acc(acc, p.h + (size_t)mt * 128 * 1024, 1024, p.Wt_in + (size_t)nt * 128 * 1024, 1024, 1024, sm, pre, nA, 1024, nB, 1024);
      pre = (tn >= 0);
      const int row0 = mt * 128 + wr * 64 + fr;
      if (nt < 72) {
        bf16_t* dst; int ldc, cb;
        if (nt < 8) { dst = p.P_rqk; ldc = 1024; cb = nt * 128; }
        else if (nt < 16) { dst = p.P_rv; ldc = 1024; cb = (nt - 8) * 128; }
        else if (nt < 24) { dst = p.P_rg; ldc = 1024; cb = (nt - 16) * 128; }
        else if (nt < 48) { dst = p.P_qkv; ldc = 3072; cb = (nt - 24) * 128; }
        else if (nt < 56) { dst = p.P_z; ldc = 1024; cb = (nt - 48) * 128; }
        else if (nt < 64) { dst = p.P_ga; ldc = 1024; cb = (nt - 56) * 128; }
        else { dst = p.P_gb; ldc = 1024; cb = (nt - 64) * 128; }
#pragma unroll
        for (int ci = 0; ci < 4; ++ci)
#pragma unroll
          for (int ri = 0; ri < 4; ++ri) {
            const int row = row0 + ri * 16, col = cb + wc * 64 + ci * 16 + fq * 4;
            *reinterpret_cast<uint2*>(dst + (size_t)row * ldc + col) = pack4(acc[ci][ri][0], acc[ci][ri][1], acc[ci][ri][2], acc[ci][ri][3]);
          }
      } else if (wc == 0) {
#pragma unroll
        for (int ri = 0; ri < 4; ++ri) {
          const int row = row0 + ri * 16;
#pragma unroll
          for (int j = 0; j < 4; ++j) {
            const int c = fq * 4 + j;
            const float v = acc[0][ri][j];
            if (c < 8) p.beta[(size_t)row * 8 + c] = sigmoidf_(v);
            else {
              const int hh = c - 8;
              const float xx = v + p.dt_bias[hh];
              const float sp = fmaxf(xx, 0.f) + log1pf(__expf(-fabsf(xx)));
              p.gl[(size_t)row * 8 + hh] = -__expf(p.a_log[hh]) * sp;
            }
          }
        }
      }
    } else {
      const int t2 = t - nMain - 129;
      const int mt = t2 >> 4, nt = t2 & 15;
      gemm_acc(acc, p.mn + (size_t)mt * 128 * 1024, 1024, p.Wt_kv + (size_t)nt * 128 * 1024, 1024, 1024, sm, pre, nA, 1024, nB, 1024);
      pre = (tn >= 0);
      const int row0 = mt * 128 + wr * 64 + fr;
#pragma unroll
      for (int ci = 0; ci < 4; ++ci)
#pragma unroll
        for (int ri = 0; ri < 4; ++ri) {
          const int row = row0 + ri * 16, col = nt * 128 + wc * 64 + ci * 16 + fq * 4;
          const float4 v = make_float4(acc[ci][ri][0], acc[ci][ri][1], acc[ci][ri][2], acc[ci][ri][3]);
          if (col < 1024) {
            *reinterpret_cast<float4*>(p.out + OUT_MK_P + (size_t)row * 1024 + col) = v;
            *reinterpret_cast<uint2*>(p.mkb + (size_t)row * 1024 + col) = pack4(v.x, v.y, v.z, v.w);
          } else {
            const int c2 = col - 1024;
            *reinterpret_cast<float4*>(p.out + OUT_MV_P + (size_t)row * 1024 + c2) = v;
            const int b = row >> 8, key = row & 255, hh = c2 >> 8, d = c2 & 255;
            bf16_t* o = p.mvT + ((size_t)(b * 4 + hh) * 256 + d) * 256 + key;
            o[0] = f2bf(v.x); o[256] = f2bf(v.y); o[512] = f2bf(v.z); o[768] = f2bf(v.w);
          }
        }
    }
  }
}

__device__ __forceinline__ void gdn_pre(const Params& p, int item, unsigned char* smraw) {
  int tid_ = threadIdx.x;
  asm volatile("" : "+v"(tid_));
  const int tid = tid_, lane = tid & 63, w = tid >> 6;
  const int fr = lane & 15, fq = lane >> 4;
  const int h = item & 7, n = (item >> 3) & 31, b = item >> 8;
  const int pit = (b * 8 + h) * 32 + n;
  bf16_t* q_s = (bf16_t*)smraw;
  float* A_s = (float*)smraw;
  bf16_t* k_s = q_s + 64 * 136;
  bf16_t* kT = k_s + 64 * 136;
  bf16_t* vT = kT + 128 * 72;
  float* gc = (float*)(vT + 128 * 72);
  float* bt = gc + 64;
  float* eg = bt + 64;
  const size_t row0 = (size_t)b * 2048 + n * 64;
  if (tid < 64) {
    float g = p.gl[(row0 + tid) * 8 + h];
    for (int off = 1; off < 64; off <<= 1) { float t = __shfl_up(g, off); if (lane >= off) g += t; }
    gc[tid] = g; bt[tid] = p.beta[(row0 + tid) * 8 + h]; eg[tid] = __expf(g);
  }
  __syncthreads();
  const float glast = gc[63];
  {
    const int cc = tid & 15, rg4 = (tid >> 4) * 4;
#pragma unroll 1
    for (int mat = 0; mat < 3; ++mat) {
      const int chb = mat * 1024 + h * 128 + cc * 8;
      uint4 raw[7];
#pragma unroll
      for (int d = 0; d < 7; ++d) {
        const int t = n * 64 + rg4 - 3 + d;
        const int tcl = t < 0 ? 0 : t;
        raw[d] = *reinterpret_cast<const uint4*>(p.P_qkv + ((size_t)b * 2048 + tcl) * 3072 + chb);
      }
      float wv[4][8];
#pragma unroll
      for (int tap = 0; tap < 4; ++tap) {
        const float4 a = *reinterpret_cast<const float4*>(p.conv_w + tap * 3072 + chb);
        const float4 c = *reinterpret_cast<const float4*>(p.conv_w + tap * 3072 + chb + 4);
        wv[tap][0] = a.x; wv[tap][1] = a.y; wv[tap][2] = a.z; wv[tap][3] = a.w;
        wv[tap][4] = c.x; wv[tap][5] = c.y; wv[tap][6] = c.z; wv[tap][7] = c.w;
      }
#pragma unroll
      for (int d = 0; d < 7; ++d)
        if (n * 64 + rg4 - 3 + d < 0) raw[d] = make_uint4(0u, 0u, 0u, 0u);
#pragma unroll
      for (int i = 0; i < 4; ++i) {
        const int r = rg4 + i;
        float a8[8];
#pragma unroll
        for (int e = 0; e < 8; ++e) a8[e] = 0.f;
#pragma unroll
        for (int tap = 0; tap < 4; ++tap) {
          float xt[8]; unpack8(raw[i + tap], xt);
#pragma unroll
          for (int e = 0; e < 8; ++e) a8[e] += wv[tap][e] * xt[e];
        }
#pragma unroll
        for (int e = 0; e < 8; ++e) a8[e] = siluf_(a8[e]);
        if (mat < 2) {
          float ss = 0.f;
#pragma unroll
          for (int e = 0; e < 8; ++e) ss += a8[e] * a8[e];
          ss += __shfl_xor(ss, 1); ss += __shfl_xor(ss, 2); ss += __shfl_xor(ss, 4); ss += __shfl_xor(ss, 8);
          float sc = rsqrtf(ss + EPSF);
          if (mat == 0) sc *= 0.08838834764831845f;
#pragma unroll
          for (int e = 0; e < 8; ++e) a8[e] *= sc;
        }
        if (mat == 0) {
          *reinterpret_cast<uint4*>(q_s + r * 136 + cc * 8) = pack8(a8);
          const float egr = eg[r];
          float qh[8];
#pragma unroll
          for (int e = 0; e < 8; ++e) qh[e] = a8[e] * egr;
          *reinterpret_cast<uint4*>(p.g_QH + (size_t)pit * 8192 + r * 128 + cc * 8) = pack8(qh);
        } else if (mat == 1) {
          *reinterpret_cast<uint4*>(k_s + r * 136 + cc * 8) = pack8(a8);
#pragma unroll
          for (int e = 0; e < 8; ++e) kT[(cc * 8 + e) * 72 + r] = f2bf(a8[e]);
        } else {
#pragma unroll
          for (int e = 0; e < 8; ++e) vT[(cc * 8 + e) * 72 + r] = f2bf(a8[e]);
        }
        asm volatile("" ::: "memory");
      }
    }
  }
  if (n == 31 && tid < 144) {
    const int i = tid / 48, ch = tid % 48, mat = ch >> 4, c16 = ch & 15;
    const int col = mat * 1024 + h * 128 + c16 * 8;
    const uint4 raw = *reinterpret_cast<const uint4*>(p.P_qkv + ((size_t)b * 2048 + 2045 + i) * 3072 + col);
    float x[8]; unpack8(raw, x);
    float* o = p.out + OUT_SC_P + ((size_t)b * 3 + i) * 3072 + col;
    *reinterpret_cast<float4*>(o) = make_float4(x[0], x[1], x[2], x[3]);
    *reinterpret_cast<float4*>(o + 4) = make_float4(x[4], x[5], x[6], x[7]);
  }
  __syncthreads();
  float Aval[4][4];
  {
    f32x4 akk[4], aqk[4];
#pragma unroll
    for (int ct = 0; ct < 4; ++ct) { akk[ct] = f32x4{0, 0, 0, 0}; aqk[ct] = f32x4{0, 0, 0, 0}; }
#pragma unroll
    for (int ks = 0; ks < 4; ++ks) {
      const bf16x8 bk = ldfrag(k_s + (16 * w + fr) * 136 + ks * 32 + fq * 8);
      const bf16x8 bq = ldfrag(q_s + (16 * w + fr) * 136 + ks * 32 + fq * 8);
#pragma unroll
      for (int ct = 0; ct < 4; ++ct) {
        const bf16x8 a = ldfrag(k_s + (ct * 16 + fr) * 136 + ks * 32 + fq * 8);
        akk[ct] = mfma16(a, bk, akk[ct]);
        aqk[ct] = mfma16(a, bq, aqk[ct]);
      }
    }
    const int i = 16 * w + fr;
    const float gi = gc[i], bi = bt[i];
#pragma unroll
    for (int ct = 0; ct < 4; ++ct) {
      float qv[4];
#pragma unroll
      for (int j = 0; j < 4; ++j) {
        const int jj = ct * 16 + fq * 4 + j;
        const float d = (i >= jj) ? __expf(gi - gc[jj]) : 0.f;
        Aval[ct][j] = (i > jj) ? akk[ct][j] * d * bi : 0.f;
        qv[j] = aqk[ct][j] * d;
      }
      *reinterpret_cast<uint2*>(p.g_QK + (size_t)pit * 4096 + i * 64 + ct * 16 + fq * 4) = pack4(qv[0], qv[1], qv[2], qv[3]);
    }
  }
  __syncthreads();
  {
    const int i = 16 * w + fr;
#pragma unroll
    for (int ct = 0; ct < 4; ++ct)
#pragma unroll
      for (int j = 0; j < 4; ++j) A_s[(ct * 16 + fq * 4 + j) * 64 + i] = Aval[ct][j];
  }
  __syncthreads();
  float* T_f = (float*)k_s;
  bf16_t* T_b = q_s;
  if (w == 0) {
    const int c = lane;
    for (int rb = 0; rb < 4; ++rb) {
      float acc[16];
#pragma unroll
      for (int ii = 0; ii < 16; ++ii) acc[ii] = (16 * rb + ii == c) ? 1.f : 0.f;
      for (int j = 0; j < 16 * rb; ++j) {
        const float tj = T_f[j * 64 + c];
        const float* ap = A_s + j * 64 + 16 * rb;
        const float4 a0 = *reinterpret_cast<const float4*>(ap), a1 = *reinterpret_cast<const float4*>(ap + 4);
        const float4 a2 = *reinterpret_cast<const float4*>(ap + 8), a3 = *reinterpret_cast<const float4*>(ap + 12);
        acc[0] -= a0.x * tj; acc[1] -= a0.y * tj; acc[2] -= a0.z * tj; acc[3] -= a0.w * tj;
        acc[4] -= a1.x * tj; acc[5] -= a1.y * tj; acc[6] -= a1.z * tj; acc[7] -= a1.w * tj;
        acc[8] -= a2.x * tj; acc[9] -= a2.y * tj; acc[10] -= a2.z * tj; acc[11] -= a2.w * tj;
        acc[12] -= a3.x * tj; acc[13] -= a3.y * tj; acc[14] -= a3.z * tj; acc[15] -= a3.w * tj;
      }
#pragma unroll
      for (int jj = 0; jj < 16; ++jj) {
        const float tj = acc[jj];
        const float* ap = A_s + (16 * rb + jj) * 64 + 16 * rb;
        const float4 a0 = *reinterpret_cast<const float4*>(ap), a1 = *reinterpret_cast<const float4*>(ap + 4);
        const float4 a2 = *reinterpret_cast<const float4*>(ap + 8), a3 = *reinterpret_cast<const float4*>(ap + 12);
        const float av[16] = {a0.x, a0.y, a0.z, a0.w, a1.x, a1.y, a1.z, a1.w, a2.x, a2.y, a2.z, a2.w, a3.x, a3.y, a3.z, a3.w};
#pragma unroll
        for (int ii = 0; ii < 16; ++ii) if (ii > jj) acc[ii] -= av[ii] * tj;
      }
#pragma unroll
      for (int ii = 0; ii < 16; ++ii) T_f[(16 * rb + ii) * 64 + c] = acc[ii];
    }
  }
  __syncthreads();
  {
    const int i = tid >> 2, c0 = (tid & 3) * 16;
    float v[16];
#pragma unroll
    for (int e = 0; e < 16; ++e) v[e] = T_f[i * 64 + c0 + e] * bt[c0 + e];
    *reinterpret_cast<uint4*>(T_b + i * 72 + c0) = pack8(v);
    *reinterpret_cast<uint4*>(T_b + i * 72 + c0 + 8) = pack8(v + 8);
  }
  __syncthreads();
  {
    f32x4 ua[8];
#pragma unroll
    for (int nt = 0; nt < 8; ++nt) ua[nt] = f32x4{0, 0, 0, 0};
#pragma unroll
    for (int ks = 0; ks < 2; ++ks) {
      const bf16x8 a = ldfrag(T_b + (16 * w + fr) * 72 + ks * 32 + fq * 8);
#pragma unroll
      for (int nt = 0; nt < 8; ++nt) ua[nt] = mfma16(a, ldfrag(vT + (nt * 16 + fr) * 72 + ks * 32 + fq * 8), ua[nt]);
    }
#pragma unroll
    for (int nt = 0; nt < 8; ++nt)
      *reinterpret_cast<uint2*>(p.g_U + (size_t)pit * 8192 + ((w * 8 + nt) * 64 + lane) * 4) = pack4(ua[nt][0], ua[nt][1], ua[nt][2], ua[nt][3]);
  }
  __syncthreads();
  {
    const int i = tid >> 2, c0 = (tid & 3) * 16;
    float v[16];
#pragma unroll
    for (int e = 0; e < 16; ++e) v[e] = T_f[i * 64 + c0 + e] * bt[c0 + e] * eg[c0 + e];
    *reinterpret_cast<uint4*>(T_b + i * 72 + c0) = pack8(v);
    *reinterpret_cast<uint4*>(T_b + i * 72 + c0 + 8) = pack8(v + 8);
  }
  __syncthreads();
  {
    f32x4 wa[8];
#pragma unroll
    for (int mt = 0; mt < 8; ++mt) wa[mt] = f32x4{0, 0, 0, 0};
#pragma unroll
    for (int ks = 0; ks < 2; ++ks) {
      const bf16x8 bfr = ldfrag(T_b + (16 * w + fr) * 72 + ks * 32 + fq * 8);
#pragma unroll
      for (int mt = 0; mt < 8; ++mt) wa[mt] = mfma16(ldfrag(kT + (mt * 16 + fr) * 72 + ks * 32 + fq * 8), bfr, wa[mt]);
    }
#pragma unroll
    for (int mt = 0; mt < 8; ++mt)
      *reinterpret_cast<uint2*>(p.g_W + (size_t)pit * 8192 + (16 * w + fr) * 128 + mt * 16 + fq * 4) = pack4(wa[mt][0], wa[mt][1], wa[mt][2], wa[mt][3]);
  }
#pragma unroll
  for (int i = 0; i < 4; ++i) {
    const int id = tid + 256 * i, r = id >> 3, c = id & 7;
    *reinterpret_cast<uint4*>(p.g_KT + (size_t)pit * 8192 + r * 64 + c * 8) = *reinterpret_cast<const uint4*>(kT + r * 72 + c * 8);
  }
  if (tid < 64) p.g_GS[(size_t)pit * 128 + tid] = __expf(glast - gc[tid]);
  if (tid == 64) p.g_GS[(size_t)pit * 128 + 64] = __expf(glast);
  __syncthreads();
}

__device__ __forceinline__ void ret_pre(const Params& p, int item, unsigned char* smraw) {
  const int tid = threadIdx.x, lane = tid & 63, w = tid >> 6;
  const int fr = lane & 15, fq = lane >> 4;
  const int h = item & 3, n = (item >> 2) & 31, b = item >> 7;
  const int pit = (b * 4 + h) * 32 + n;
  bf16_t* q_s = (bf16_t*)smraw;
  bf16_t* k_s = q_s + 64 * 136;
  bf16_t* kT = k_s + 64 * 136;
  const float log_g = log1pf(-exp2f(-5.f - (float)h));
#pragma unroll
  for (int i = 0; i < 2; ++i) {
    const int id = tid + 256 * i, r = id >> 3, cc = id & 7;
    const int pos = n * 64 + r;
    float cs[8], sn[8];
    {
      const float4 c0 = *reinterpret_cast<const float4*>(p.ropec + pos * 64 + cc * 8);
      const float4 c1 = *reinterpret_cast<const float4*>(p.ropec + pos * 64 + cc * 8 + 4);
      const float4 s0 = *reinterpret_cast<const float4*>(p.ropes + pos * 64 + cc * 8);
      const float4 s1 = *reinterpret_cast<const float4*>(p.ropes + pos * 64 + cc * 8 + 4);
      cs[0] = c0.x; cs[1] = c0.y; cs[2] = c0.z; cs[3] = c0.w; cs[4] = c1.x; cs[5] = c1.y; cs[6] = c1.z; cs[7] = c1.w;
      sn[0] = s0.x; sn[1] = s0.y; sn[2] = s0.z; sn[3] = s0.w; sn[4] = s1.x; sn[5] = s1.y; sn[6] = s1.z; sn[7] = s1.w;
    }
    const size_t grow = ((size_t)b * 2048 + pos) * 1024;
#pragma unroll
    for (int mat = 0; mat < 2; ++mat) {
      const bf16_t* src = p.P_rqk + grow + mat * 512 + h * 128;
      float x1[8], x2[8], o1[8], o2[8];
      unpack8(*reinterpret_cast<const uint4*>(src + cc * 8), x1);
      unpack8(*reinterpret_cast<const uint4*>(src + 64 + cc * 8), x2);
      const float sc = mat ? 0.08838834764831845f : 1.f;
#pragma unroll
      for (int e = 0; e < 8; ++e) {
        o1[e] = (x1[e] * cs[e] - x2[e] * sn[e]) * sc;
        o2[e] = (x1[e] * sn[e] + x2[e] * cs[e]) * sc;
      }
      if (mat == 0) {
        *reinterpret_cast<uint4*>(q_s + r * 136 + cc * 8) = pack8(o1);
        *reinterpret_cast<uint4*>(q_s + r * 136 + 64 + cc * 8) = pack8(o2);
        const float qd = __expf((float)(r + 1) * log_g);
#pragma unroll
        for (int e = 0; e < 8; ++e) { o1[e] *= qd; o2[e] *= qd; }
        *reinterpret_cast<uint4*>(p.r_QD + (size_t)pit * 8192 + r * 128 + cc * 8) = pack8(o1);
        *reinterpret_cast<uint4*>(p.r_QD + (size_t)pit * 8192 + r * 128 + 64 + cc * 8) = pack8(o2);
      } else {
        *reinterpret_cast<uint4*>(k_s + r * 136 + cc * 8) = pack8(o1);
        *reinterpret_cast<uint4*>(k_s + r * 136 + 64 + cc * 8) = pack8(o2);
        const float kd = __expf((float)(63 - r) * log_g);
#pragma unroll
        for (int e = 0; e < 8; ++e) {
          kT[(cc * 8 + e) * 72 + r] = f2bf(o1[e] * kd);
          kT[(64 + cc * 8 + e) * 72 + r] = f2bf(o2[e] * kd);
        }
      }
    }
  }
  __syncthreads();
  {
    f32x4 sc[4];
#pragma unroll
    for (int ct = 0; ct < 4; ++ct) sc[ct] = f32x4{0, 0, 0, 0};
#pragma unroll
    for (int ks = 0; ks < 4; ++ks) {
      const bf16x8 bq = ldfrag(q_s + (16 * w + fr) * 136 + ks * 32 + fq * 8);
#pragma unroll
      for (int ct = 0; ct < 4; ++ct) sc[ct] = mfma16(ldfrag(k_s + (ct * 16 + fr) * 136 + ks * 32 + fq * 8), bq, sc[ct]);
    }
    const int i = 16 * w + fr;
#pragma unroll
    for (int ct = 0; ct < 4; ++ct) {
      float v[4];
#pragma unroll
      for (int j = 0; j < 4; ++j) {
        const int jj = ct * 16 + fq * 4 + j;
        v[j] = (i >= jj) ? sc[ct][j] * __expf((float)(i - jj) * log_g) : 0.f;
      }
      *reinterpret_cast<uint2*>(p.r_SC + (size_t)pit * 4096 + i * 64 + ct * 16 + fq * 4) = pack4(v[0], v[1], v[2], v[3]);
    }
  }
#pragma unroll
  for (int i = 0; i < 4; ++i) {
    const int id = tid + 256 * i, r = id >> 3, c = id & 7;
    *reinterpret_cast<uint4*>(p.r_KDT + (size_t)pit * 8192 + r * 64 + c * 8) = *reinterpret_cast<const uint4*>(kT + r * 72 + c * 8);
  }
  __syncthreads();
}

__device__ __forceinline__ void phase2(const Params& p, unsigned char* smraw) {
  const int G = gridDim.x;
#ifndef P2MASK
#define P2MASK 3
#endif
  if (P2MASK & 1) for (int it = first_item(0); it < 2048; it += G) gdn_pre(p, it, smraw);
  if (P2MASK & 2) for (int it = first_item(2048); it < 3072; it += G) ret_pre(p, it - 2048, smraw);
}

__device__ __forceinline__ void gdn_seq(const Params& p, int bh, int sl, unsigned char* smraw) {
  const int tid = threadIdx.x, lane = tid & 63, w = tid >> 6;
  const int fr = lane & 15, fq = lane >> 4;
  const int b = bh >> 3, h = bh & 7;
  bf16_t* ST = (bf16_t*)smraw;
  bf16_t* vT = ST + 32 * 136;
  bf16_t* vTs = vT + 32 * 72;
  f32x4 sacc[2][2];
#pragma unroll
  for (int a = 0; a < 2; ++a)
#pragma unroll
    for (int c = 0; c < 2; ++c) sacc[a][c] = f32x4{0, 0, 0, 0};
  for (int idx = tid; idx < 32 * 136 / 2; idx += 256) ((unsigned*)ST)[idx] = 0u;
  __syncthreads();
  struct Ops { bf16x8 wf[4], qhf[4], qkf[2], ktf[2][2]; uint2 uu[2]; float4 ds; float egl; };
  auto load = [&](Ops& o, int n) __attribute__((always_inline)) {
    const size_t item = (size_t)bh * 32 + n;
    const bf16_t* W = p.g_W + item * 8192 + (16 * w + fr) * 128 + fq * 8;
    const bf16_t* QH = p.g_QH + item * 8192 + (16 * w + fr) * 128 + fq * 8;
    const bf16_t* QK = p.g_QK + item * 4096 + (16 * w + fr) * 64 + fq * 8;
    const bf16_t* KT = p.g_KT + item * 8192 + (32 * w + fr) * 64 + fq * 8;
#pragma unroll
    for (int ks = 0; ks < 4; ++ks) { o.wf[ks] = ldfrag(W + ks * 32); o.qhf[ks] = ldfrag(QH + ks * 32); }
#pragma unroll
    for (int ks = 0; ks < 2; ++ks) {
      o.qkf[ks] = ldfrag(QK + ks * 32);
      o.ktf[0][ks] = ldfrag(KT + ks * 32);
      o.ktf[1][ks] = ldfrag(KT + 16 * 64 + ks * 32);
    }
#pragma unroll
    for (int nt = 0; nt < 2; ++nt) o.uu[nt] = *reinterpret_cast<const uint2*>(p.g_U + item * 8192 + ((w * 8 + sl * 2 + nt) * 64 + lane) * 4);
    o.ds = *reinterpret_cast<const float4*>(p.g_GS + item * 128 + 16 * w + fq * 4);
    o.egl = p.g_GS[item * 128 + 64];
  };
  auto step = [&](const Ops& o, int n) __attribute__((always_inline)) {
    f32x4 pacc[2];
#pragma unroll
    for (int nt = 0; nt < 2; ++nt) {
      pacc[nt] = f32x4{0, 0, 0, 0};
#pragma unroll
      for (int ks = 0; ks < 4; ++ks) pacc[nt] = mfma16(o.wf[ks], ldfrag(ST + (nt * 16 + fr) * 136 + ks * 32 + fq * 8), pacc[nt]);
    }
    const float dsv[4] = {o.ds.x, o.ds.y, o.ds.z, o.ds.w};
#pragma unroll
    for (int nt = 0; nt < 2; ++nt) {
      float u[4]; unpack4(o.uu[nt], u);
      float vn[4], vs[4];
#pragma unroll
      for (int j = 0; j < 4; ++j) { vn[j] = u[j] - pacc[nt][j]; vs[j] = vn[j] * dsv[j]; }
      *reinterpret_cast<uint2*>(vT + (nt * 16 + fr) * 72 + 16 * w + fq * 4) = pack4(vn[0], vn[1], vn[2], vn[3]);
      *reinterpret_cast<uint2*>(vTs + (nt * 16 + fr) * 72 + 16 * w + fq * 4) = pack4(vs[0], vs[1], vs[2], vs[3]);
    }
    __syncthreads();
    f32x4 oacc[2];
#pragma unroll
    for (int nt = 0; nt < 2; ++nt) {
      oacc[nt] = f32x4{0, 0, 0, 0};
#pragma unroll
      for (int ks = 0; ks < 4; ++ks) oacc[nt] = mfma16(o.qhf[ks], ldfrag(ST + (nt * 16 + fr) * 136 + ks * 32 + fq * 8), oacc[nt]);
#pragma unroll
      for (int ks = 0; ks < 2; ++ks) oacc[nt] = mfma16(o.qkf[ks], ldfrag(vT + (nt * 16 + fr) * 72 + ks * 32 + fq * 8), oacc[nt]);
    }
#pragma unroll
    for (int mt = 0; mt < 2; ++mt)
#pragma unroll
      for (int nt = 0; nt < 2; ++nt) {
#pragma unroll
        for (int j = 0; j < 4; ++j) sacc[mt][nt][j] *= o.egl;
#pragma unroll
        for (int ks = 0; ks < 2; ++ks) sacc[mt][nt] = mfma16(o.ktf[mt][ks], ldfrag(vTs + (nt * 16 + fr) * 72 + ks * 32 + fq * 8), sacc[mt][nt]);
      }
    {
      bf16_t* og = p.o_g + ((size_t)b * 2048 + n * 64 + 16 * w + fq * 4) * 1024 + h * 128 + sl * 32 + fr;
#pragma unroll
      for (int nt = 0; nt < 2; ++nt)
#pragma unroll
        for (int j = 0; j < 4; ++j) og[(size_t)j * 1024 + nt * 16] = f2bf(oacc[nt][j]);
    }
    __syncthreads();
#pragma unroll
    for (int mt = 0; mt < 2; ++mt)
#pragma unroll
      for (int nt = 0; nt < 2; ++nt)
        *reinterpret_cast<uint2*>(ST + (nt * 16 + fr) * 136 + 32 * w + mt * 16 + fq * 4) = pack4(sacc[mt][nt][0], sacc[mt][nt][1], sacc[mt][nt][2], sacc[mt][nt][3]);
    __syncthreads();
  };
  Ops oa, ob;
  load(oa, 0);
  for (int n = 0; n < 32; n += 2) {
    load(ob, n + 1);
    step(oa, n);
    if (n + 2 < 32) load(oa, n + 2);
    step(ob, n + 1);
  }
  float* so = p.out + OUT_SG_P + ((size_t)bh * 128 + 32 * w + fq * 4) * 128 + sl * 32 + fr;
#pragma unroll
  for (int mt = 0; mt < 2; ++mt)
#pragma unroll
    for (int nt = 0; nt < 2; ++nt)
#pragma unroll
      for (int j = 0; j < 4; ++j) so[(size_t)(mt * 16 + j) * 128 + nt * 16] = sacc[mt][nt][j];
  __syncthreads();
}

__device__ __forceinline__ void ret_seq(const Params& p, int bh, int sl, unsigned char* smraw) {
  const int tid = threadIdx.x, lane = tid & 63, w = tid >> 6;
  const int fr = lane & 15, fq = lane >> 4;
  const int b = bh >> 2, h = bh & 3;
  bf16_t* ST = (bf16_t*)smraw;
  bf16_t* vT = ST + 32 * 136;
  const float log_g = log1pf(-exp2f(-5.f - (float)h));
  const float cd = __expf(64.f * log_g);
  f32x4 sacc[2][2];
#pragma unroll
  for (int a = 0; a < 2; ++a)
#pragma unroll
    for (int c = 0; c < 2; ++c) sacc[a][c] = f32x4{0, 0, 0, 0};
  struct Ops { bf16x8 qdf[4], scf[2], kdf[2][2]; uint4 vr; };
  const int vrow = tid & 63, vc8 = (tid >> 6) * 8;
  auto load = [&](Ops& o, int n) __attribute__((always_inline)) {
    const size_t item = (size_t)bh * 32 + n;
    const bf16_t* QD = p.r_QD + item * 8192 + (16 * w + fr) * 128 + fq * 8;
    const bf16_t* SC = p.r_SC + item * 4096 + (16 * w + fr) * 64 + fq * 8;
    const bf16_t* KD = p.r_KDT + item * 8192 + (32 * w + fr) * 64 + fq * 8;
#pragma unroll
    for (int ks = 0; ks < 4; ++ks) o.qdf[ks] = ldfrag(QD + ks * 32);
#pragma unroll
    for (int ks = 0; ks < 2; ++ks) {
      o.scf[ks] = ldfrag(SC + ks * 32);
      o.kdf[0][ks] = ldfrag(KD + ks * 32);
      o.kdf[1][ks] = ldfrag(KD + 16 * 64 + ks * 32);
    }
    o.vr = *reinterpret_cast<const uint4*>(p.P_rv + ((size_t)b * 2048 + n * 64 + vrow) * 1024 + h * 256 + sl * 32 + vc8);
  };
  auto step = [&](const Ops& o, int n) __attribute__((always_inline)) {
    {
      float v8[8]; unpack8(o.vr, v8);
#pragma unroll
      for (int e = 0; e < 8; ++e) vT[(vc8 + e) * 72 + vrow] = f2bf(v8[e]);
    }
#pragma unroll
    for (int mt = 0; mt < 2; ++mt)
#pragma unroll
      for (int nt = 0; nt < 2; ++nt)
        *reinterpret_cast<uint2*>(ST + (nt * 16 + fr) * 136 + 32 * w + mt * 16 + fq * 4) = pack4(sacc[mt][nt][0], sacc[mt][nt][1], sacc[mt][nt][2], sacc[mt][nt][3]);
    __syncthreads();
    f32x4 oacc[2];
#pragma unroll
    for (int nt = 0; nt < 2; ++nt) {
      oacc[nt] = f32x4{0, 0, 0, 0};
#pragma unroll
      for (int ks = 0; ks < 4; ++ks) oacc[nt] = mfma16(o.qdf[ks], ldfrag(ST + (nt * 16 + fr) * 136 + ks * 32 + fq * 8), oacc[nt]);
#pragma unroll
      for (int ks = 0; ks < 2; ++ks) oacc[nt] = mfma16(o.scf[ks], ldfrag(vT + (nt * 16 + fr) * 72 + ks * 32 + fq * 8), oacc[nt]);
    }
#pragma unroll
    for (int mt = 0; mt < 2; ++mt)
#pragma unroll
      for (int nt = 0; nt < 2; ++nt) {
#pragma unroll
        for (int j = 0; j < 4; ++j) sacc[mt][nt][j] *= cd;
#pragma unroll
        for (int ks = 0; ks < 2; ++ks) sacc[mt][nt] = mfma16(o.kdf[mt][ks], ldfrag(vT + (nt * 16 + fr) * 72 + ks * 32 + fq * 8), sacc[mt][nt]);
      }
    {
      bf16_t* og = p.o_r + ((size_t)b * 2048 + n * 64 + 16 * w + fq * 4) * 1024 + h * 256 + sl * 32 + fr;
#pragma unroll
      for (int nt = 0; nt < 2; ++nt)
#pragma unroll
        for (int j = 0; j < 4; ++j) og[(size_t)j * 1024 + nt * 16] = f2bf(oacc[nt][j]);
    }
    __syncthreads();
  };
  Ops oa, ob;
  load(oa, 0);
  for (int n = 0; n < 32; n += 2) {
    load(ob, n + 1);
    step(oa, n);
    if (n + 2 < 32) load(oa, n + 2);
    step(ob, n + 1);
  }
  float* so = p.out + OUT_SR_P + ((size_t)bh * 128 + 32 * w + fq * 4) * 256 + sl * 32 + fr;
#pragma unroll
  for (int mt = 0; mt < 2; ++mt)
#pragma unroll
    for (int nt = 0; nt < 2; ++nt)
#pragma unroll
      for (int j = 0; j < 4; ++j) so[(size_t)(mt * 16 + j) * 256 + nt * 16] = sacc[mt][nt][j];
}

__device__ __forceinline__ void ret_sample(const Params& p, int item, unsigned char* smraw) {
  const int tid = threadIdx.x, lane = tid & 63, w = tid >> 6;
  const int b = item >> 2, h = item & 3;
  const size_t row = NPR + b;
  float* qs = (float*)smraw;
  float* ks = qs + 128;
  float* red = ks + 128;
  const float gam = 1.f - exp2f(-5.f - (float)h);
  if (tid < 128) {
    const int mat = tid >> 6, i = tid & 63;
    const bf16_t* src = p.P_rqk + row * 1024 + mat * 512 + h * 128;
    const float x1 = bf2f(src[i]), x2 = bf2f(src[i + 64]);
    const float c = p.ropec[2048 * 64 + i], s = p.ropes[2048 * 64 + i];
    const float sc = mat ? 0.08838834764831845f : 1.f;
    float* d = mat ? ks : qs;
    d[i] = (x1 * c - x2 * s) * sc;
    d[i + 64] = (x1 * s + x2 * c) * sc;
  }
  __syncthreads();
  const int c4 = lane * 4;
  float v4[4];
  unpack4(*reinterpret_cast<const uint2*>(p.P_rv + row * 1024 + h * 256 + c4), v4);
  const float* S = p.state_ret + ((size_t)(b * 4 + h) * 128) * 256;
  float* So = p.out + OUT_SR_S + ((size_t)(b * 4 + h) * 128) * 256;
  float o0 = 0.f, o1 = 0.f, o2 = 0.f, o3 = 0.f;
#pragma unroll 8
  for (int i = 0; i < 32; ++i) {
    const int k = w + 4 * i;
    const float4 s = ldnt4(S + (size_t)k * 256 + c4);
    const float kk = ks[k], qq = qs[k];
    float4 sn;
    sn.x = gam * s.x + kk * v4[0]; sn.y = gam * s.y + kk * v4[1]; sn.z = gam * s.z + kk * v4[2]; sn.w = gam * s.w + kk * v4[3];
    stnt4(So + (size_t)k * 256 + c4, sn);
    o0 += qq * sn.x; o1 += qq * sn.y; o2 += qq * sn.z; o3 += qq * sn.w;
  }
  *reinterpret_cast<float4*>(red + w * 256 + c4) = make_float4(o0, o1, o2, o3);
  __syncthreads();
  {
    const float o = red[tid] + red[256 + tid] + red[512 + tid] + red[768 + tid];
    p.o_r[row * 1024 + h * 256 + tid] = f2bf(o);
  }
  __syncthreads();
}

__device__ __forceinline__ void gdn_sample(const Params& p, int item, unsigned char* smraw) {
  const int tid = threadIdx.x, lane = tid & 63, w = tid >> 6;
  const int b = item >> 3, h = item & 7;
  const size_t row = NPR + b;
  float* cv = (float*)smraw;
  float* red = cv + 384;
  float* misc = red + 2048;
  for (int ch = tid; ch < 384; ch += 256) {
    const int mat = ch >> 7, c = ch & 127;
    const int col = mat * 1024 + h * 128 + c;
    const float x = bf2f(p.P_qkv[row * 3072 + col]);
    const float b0 = p.state_conv[((size_t)b * 3 + 0) * 3072 + col];
    const float b1 = p.state_conv[((size_t)b * 3 + 1) * 3072 + col];
    const float b2 = p.state_conv[((size_t)b * 3 + 2) * 3072 + col];
    float o = p.conv_w[col] * b0 + p.conv_w[3072 + col] * b1 + p.conv_w[2 * 3072 + col] * b2 + p.conv_w[3 * 3072 + col] * x;
    cv[ch] = siluf_(o);
    float* so = p.out + OUT_SC_S + (size_t)b * 3 * 3072 + col;
    so[0] = b1; so[3072] = b2; so[2 * 3072] = x;
  }
  __syncthreads();
  if (w < 2) {
    const float a = cv[w * 128 + lane], c = cv[w * 128 + 64 + lane];
    float ss = wave_sum(a * a + c * c);
    float sc = rsqrtf(ss + EPSF);
    if (w == 0) sc *= 0.08838834764831845f;
    cv[w * 128 + lane] = a * sc; cv[w * 128 + 64 + lane] = c * sc;
  }
  __syncthreads();
  if (w == 0) {
    const float d = wave_sum(cv[lane] * cv[128 + lane] + cv[64 + lane] * cv[192 + lane]);
    if (lane == 0) misc[0] = d;
  }
  const float beta = p.beta[row * 8 + h];
  const float eg = __expf(p.gl[row * 8 + h]);
  const int c4 = (tid & 31) * 4, rg = tid >> 5;
  const float* S = p.state_gdn + ((size_t)(b * 8 + h) * 128) * 128;
  float* So = p.out + OUT_SG_S + ((size_t)(b * 8 + h) * 128) * 128;
  float4 s[16];
  float kS[4] = {0, 0, 0, 0}, qS[4] = {0, 0, 0, 0};
#pragma unroll
  for (int i = 0; i < 16; ++i) {
    const int k = rg + 8 * i;
    s[i] = ldnt4(S + (size_t)k * 128 + c4);
  }
#pragma unroll
  for (int i = 0; i < 16; ++i) {
    const int k = rg + 8 * i;
    const float kk = cv[128 + k], qq = cv[k];
    kS[0] += kk * s[i].x; kS[1] += kk * s[i].y; kS[2] += kk * s[i].z; kS[3] += kk * s[i].w;
    qS[0] += qq * s[i].x; qS[1] += qq * s[i].y; qS[2] += qq * s[i].z; qS[3] += qq * s[i].w;
  }
  *reinterpret_cast<float4*>(red + rg * 128 + c4) = make_float4(kS[0], kS[1], kS[2], kS[3]);
  *reinterpret_cast<float4*>(red + 1024 + rg * 128 + c4) = make_float4(qS[0], qS[1], qS[2], qS[3]);
  __syncthreads();
  float kSt[4] = {0, 0, 0, 0}, qSt[4] = {0, 0, 0, 0};
#pragma unroll
  for (int g = 0; g < 8; ++g) {
    const float4 a = *reinterpret_cast<const float4*>(red + g * 128 + c4);
    const float4 c = *reinterpret_cast<const float4*>(red + 1024 + g * 128 + c4);
    kSt[0] += a.x; kSt[1] += a.y; kSt[2] += a.z; kSt[3] += a.w;
    qSt[0] += c.x; qSt[1] += c.y; qSt[2] += c.z; qSt[3] += c.w;
  }
  const float qk = misc[0];
  float vn[4], o[4];
#pragma unroll
  for (int e = 0; e < 4; ++e) {
    vn[e] = beta * (cv[256 + c4 + e] - eg * kSt[e]);
    o[e] = eg * qSt[e] + qk * vn[e];
  }
#pragma unroll
  for (int i = 0; i < 16; ++i) {
    const int k = rg + 8 * i;
    const float kk = cv[128 + k];
    float4 sn;
    sn.x = eg * s[i].x + kk * vn[0]; sn.y = eg * s[i].y + kk * vn[1]; sn.z = eg * s[i].z + kk * vn[2]; sn.w = eg * s[i].w + kk * vn[3];
    stnt4(So + (size_t)k * 128 + c4, sn);
  }
  if (rg == 0) *reinterpret_cast<uint2*>(p.o_g + row * 1024 + h * 128 + c4) = pack4(o[0], o[1], o[2], o[3]);
  __syncthreads();
}

__device__ __forceinline__ void phase3(const Params& p, unsigned char* smraw) {
  const int G = gridDim.x;
#ifndef P3MASK
#define P3MASK 15
#endif
  const bool late_seq = (blockIdx.x & 256) != 0;
  if (!late_seq) {
    if (P3MASK & 1) for (int it = first_item(0); it < 256; it += G) gdn_seq(p, it & 63, it >> 6, smraw);
  }
  if (P3MASK & 4) for (int it = first_item(512); it < 1024; it += G) ret_sample(p, it - 512, smraw);
  if (P3MASK & 8) for (int it = first_item(1024); it < 2048; it += G) gdn_sample(p, it - 1024, smraw);
  if (P3MASK & 2) for (int it = first_item(256); it < 512; it += G) ret_seq(p, (it - 256) & 31, (it - 256) >> 5, smraw);
  if (late_seq) {
    if (P3MASK & 1) for (int it = first_item(0); it < 256; it += G) gdn_seq(p, it & 63, it >> 6, smraw);
  }
}

__device__ __forceinline__ void phase4(const Params& p) {
  const int tid = threadIdx.x, lane = tid & 63, wid = tid >> 6;
  for (int r = blockIdx.x * 4 + wid; r < NTOK; r += gridDim.x * 4) {
    const size_t base = (size_t)r * 1024;
    uint4 ro[2], rg[2], go[2], gz[2];
#pragma unroll
    for (int q = 0; q < 2; ++q) {
      const int c = q * 512 + lane * 8;
      ro[q] = *reinterpret_cast<const uint4*>(p.o_r + base + c);
      rg[q] = *reinterpret_cast<const uint4*>(p.P_rg + base + c);
      go[q] = *reinterpret_cast<const uint4*>(p.o_g + base + c);
      gz[q] = *reinterpret_cast<const uint4*>(p.P_z + base + c);
    }
#pragma unroll
    for (int q = 0; q < 2; ++q) {
      const int c = q * 512 + lane * 8;
      float o[8], g[8];
      unpack8(ro[q], o); unpack8(rg[q], g);
      float sm_ = 0.f;
#pragma unroll
      for (int e = 0; e < 8; ++e) sm_ += o[e];
      sm_ += __shfl_xor(sm_, 1); sm_ += __shfl_xor(sm_, 2); sm_ += __shfl_xor(sm_, 4); sm_ += __shfl_xor(sm_, 8); sm_ += __shfl_xor(sm_, 16);
      const float mu = sm_ * (1.f / 256.f);
      float vs = 0.f;
#pragma unroll
      for (int e = 0; e < 8; ++e) { o[e] -= mu; vs += o[e] * o[e]; }
      vs += __shfl_xor(vs, 1); vs += __shfl_xor(vs, 2); vs += __shfl_xor(vs, 4); vs += __shfl_xor(vs, 8); vs += __shfl_xor(vs, 16);
      const float rs = rsqrtf(vs * (1.f / 256.f) + EPSF);
      const float4 g0 = *reinterpret_cast<const float4*>(p.ret_gn_g + c), g1 = *reinterpret_cast<const float4*>(p.ret_gn_g + c + 4);
      const float gn[8] = {g0.x, g0.y, g0.z, g0.w, g1.x, g1.y, g1.z, g1.w};
      float y[8];
#pragma unroll
      for (int e = 0; e < 8; ++e) y[e] = siluf_(g[e]) * o[e] * rs * gn[e];
      *reinterpret_cast<uint4*>(p.ya + base + c) = pack8(y);
    }
#pragma unroll
    for (int q = 0; q < 2; ++q) {
      const int c = q * 512 + lane * 8;
      float o[8], z[8];
      unpack8(go[q], o); unpack8(gz[q], z);
      float ss = 0.f;
#pragma unroll
      for (int e = 0; e < 8; ++e) ss += o[e] * o[e];
      ss += __shfl_xor(ss, 1); ss += __shfl_xor(ss, 2); ss += __shfl_xor(ss, 4); ss += __shfl_xor(ss, 8);
      const float rs = rsqrtf(ss * (1.f / 128.f) + EPSF);
      const int d = (lane & 15) * 8;
      const float4 g0 = *reinterpret_cast<const float4*>(p.gdn_norm_g + d), g1 = *reinterpret_cast<const float4*>(p.gdn_norm_g + d + 4);
      const float gn[8] = {g0.x, g0.y, g0.z, g0.w, g1.x, g1.y, g1.z, g1.w};
      float y[8];
#pragma unroll
      for (int e = 0; e < 8; ++e) y[e] = o[e] * rs * gn[e] * siluf_(z[e]);
      *reinterpret_cast<uint4*>(p.yb + base + c) = pack8(y);
    }
  }
}

__device__ __forceinline__ float row_rs(const float* ss, int row) {
  const float4 a = *reinterpret_cast<const float4*>(ss + (size_t)row * 16);
  const float4 b = *reinterpret_cast<const float4*>(ss + (size_t)row * 16 + 4);
  const float4 c = *reinterpret_cast<const float4*>(ss + (size_t)row * 16 + 8);
  const float4 d = *reinterpret_cast<const float4*>(ss + (size_t)row * 16 + 12);
  const float s = ((a.x + a.y) + (a.z + a.w)) + ((b.x + b.y) + (b.z + b.w)) + ((c.x + c.y) + (c.z + c.w)) + ((d.x + d.y) + (d.z + d.w));
  return rsqrtf(s * (1.f / 1024.f) + EPSF);
}

#define SK_TILES 92
template <int MODE> struct SkOff { static constexpr int v = (MODE == 5) ? 0 : (MODE == 6) ? 16 : (MODE == 7) ? 24 : (MODE == 9) ? 32 : (MODE == 11) ? 40 : 48; };

template <int MODE>
__device__ __forceinline__ void gemm_epi(const Params& p, f32x4 (&acc)[4][4], int mt, int nt) {
  int tid_ = threadIdx.x;
  asm volatile("" : "+v"(tid_));
  const int tid = tid_, lane = tid & 63, wid = tid >> 6;
  const int wr = wid >> 1, wc = wid & 1, fr = lane & 15, fq = lane >> 4;
  const int row0 = mt * 128 + wr * 64 + fr;
  const int colb = nt * 128 + wc * 64 + fq * 4;
  if (MODE == 6 || MODE == 9 || MODE == 11) {
    bf16_t* xb = (MODE == 6) ? p.x1b : p.x2b;
    float* ssp = (MODE == 6) ? p.ss1 : (MODE == 9) ? p.ss2 : p.ss3;
#pragma unroll
    for (int ri = 0; ri < 4; ++ri) {
      const int row = row0 + ri * 16;
      float ssq = 0.f;
#pragma unroll
      for (int ci = 0; ci < 4; ++ci) {
        const size_t off = (size_t)row * 1024 + colb + ci * 16;
        float4 xin;
        if (MODE == 6) {
          const float* xs = (row < NPR) ? (p.x_prompt + off) : (p.x_sample + (off - (size_t)NPR * 1024));
          xin = *reinterpret_cast<const float4*>(xs);
        } else xin = *reinterpret_cast<const float4*>(p.out + off);
        float4 v = make_float4(xin.x + acc[ci][ri][0], xin.y + acc[ci][ri][1], xin.z + acc[ci][ri][2], xin.w + acc[ci][ri][3]);
        *reinterpret_cast<float4*>(p.out + off) = v;
        if (MODE != 11) *reinterpret_cast<uint2*>(xb + off) = pack4(v.x, v.y, v.z, v.w);
        ssq += v.x * v.x + v.y * v.y + v.z * v.z + v.w * v.w;
      }
      ssq += __shfl_xor(ssq, 16); ssq += __shfl_xor(ssq, 32);
      if (fq == 0) ssp[(size_t)row * 16 + nt * 2 + wc] = ssq;
    }
  } else if (MODE == 7) {
#pragma unroll
    for (int ri = 0; ri < 4; ++ri) {
      const int row = row0 + ri * 16;
      const float rs = row_rs(p.ss1, row);
#pragma unroll
      for (int ci = 0; ci < 4; ++ci) {
        const size_t off = (size_t)row * 1024 + colb + ci * 16;
        *reinterpret_cast<uint2*>(p.q + off) = pack4(acc[ci][ri][0] * rs, acc[ci][ri][1] * rs, acc[ci][ri][2] * rs, acc[ci][ri][3] * rs);
      }
    }
  } else if (MODE == 10) {
#pragma unroll
    for (int ri = 0; ri < 4; ++ri) {
      const int row = row0 + ri * 16;
      const float rs = row_rs(p.ss2, row);
#pragma unroll
      for (int ci = 0; ci < 4; ++ci) {
        const int f = (colb + ci * 16) >> 1;
        const float g0 = acc[ci][ri][0] * rs, u0 = acc[ci][ri][1] * rs, g1 = acc[ci][ri][2] * rs, u1 = acc[ci][ri][3] * rs;
        *reinterpret_cast<unsigned*>(p.ff + (size_t)row * 2816 + f) = pack2(siluf_(g0) * u0, siluf_(g1) * u1);
      }
    }
  }
}

template <int MODE>
__device__ __forceinline__ void gemm_phase(const Params& p, unsigned char* smraw) {
  const int tid = threadIdx.x, lane = tid & 63, wid = tid >> 6;
  const int wr = wid >> 1, wc = wid & 1, fr = lane & 15, fq = lane >> 4;
  bf16_t* sm = (bf16_t*)smraw;
  constexpr int NT = (MODE == 10) ? 44 : 8;
  constexpr int K = (MODE == 11) ? 2816 : 1024;
  const bf16_t* Aop = (MODE == 5) ? p.ya : (MODE == 6) ? p.merged : (MODE == 7) ? p.x1b : (MODE == 9) ? p.ao : (MODE == 10) ? p.x2b : p.ff;
  const bf16_t* Bop = (MODE == 5) ? p.Wt_a : (MODE == 6) ? p.Wt_out : (MODE == 7) ? p.Wt_xq : (MODE == 9) ? p.Wt_xo : (MODE == 10) ? p.Wt_gu : p.Wt_down;
  {
    const int total = 128 * NT;
    int t0, t1, tstep;
    tile_range(total, t0, t1, tstep);
    bool pre = false;
    for (int t = t0; t < t1; t += tstep) {
      int mt, nt;
      tile_decode(t, 128, NT, mt, nt);
      const bool has_next = (t + tstep < t1);
      int nmt = 0, nnt = 0;
      if (has_next) tile_decode(t + tstep, 128, NT, nmt, nnt);
      f32x4 acc[4][4];
      ZERO_ACC(acc);
      const size_t arow = (size_t)mt * 128;
      const size_t narow = (size_t)nmt * 128;
      if (MODE == 5) {
        int tq = threadIdx.x;
        asm volatile("" : "+v"(tq));
        const int row0 = mt * 128 + ((tq >> 7) & 1) * 64 + (tq & 15);
        const int colb = nt * 128 + ((tq >> 6) & 1) * 64 + ((tq >> 4) & 3) * 4;
        gemm_acc(acc, p.ya + arow * 1024, 1024, p.Wt_a + (size_t)nt * 128 * 1024, 1024, 1024, sm, pre,
                 p.yb + arow * 1024, 1024, p.Wt_b + (size_t)nt * 128 * 1024, 1024);
#pragma unroll
        for (int ci = 0; ci < 4; ++ci)
#pragma unroll
          for (int ri = 0; ri < 4; ++ri) {
            const size_t off = (size_t)(row0 + ri * 16) * 1024 + colb + ci * 16;
            float ga[4], gb[4];
            unpack4(*reinterpret_cast<const uint2*>(p.P_ga + off), ga);
            unpack4(*reinterpret_cast<const uint2*>(p.P_gb + off), gb);
#pragma unroll
            for (int j = 0; j < 4; ++j) acc[ci][ri][j] *= (1.f + __expf(-gb[j])) / (1.f + __expf(-ga[j]));
            asm volatile("" ::: "memory");
          }
        gemm_acc(acc, p.yb + arow * 1024, 1024, p.Wt_b + (size_t)nt * 128 * 1024, 1024, 1024, sm, true,
                 has_next ? p.ya + narow * 1024 : nullptr, 1024, p.Wt_a + (size_t)nnt * 128 * 1024, 1024);
        pre = has_next;
#pragma unroll
        for (int ci = 0; ci < 4; ++ci)
#pragma unroll
          for (int ri = 0; ri < 4; ++ri) {
            const size_t off = (size_t)(row0 + ri * 16) * 1024 + colb + ci * 16;
            float gb[4];
            unpack4(*reinterpret_cast<const uint2*>(p.P_gb + off), gb);
            *reinterpret_cast<uint2*>(p.merged + off) = pack4(acc[ci][ri][0] * sigmoidf_(gb[0]), acc[ci][ri][1] * sigmoidf_(gb[1]),
                                                              acc[ci][ri][2] * sigmoidf_(gb[2]), acc[ci][ri][3] * sigmoidf_(gb[3]));
            asm volatile("" ::: "memory");
          }
      } else {
        gemm_acc(acc, Aop + arow * K, K, Bop + (size_t)nt * 128 * K, K, K, sm, pre,
                 has_next ? Aop + narow * K : nullptr, K, Bop + (size_t)nnt * 128 * K, K);
        pre = has_next;
        gemm_epi<MODE>(p, acc, mt, nt);
      }
    }
  }
  {
    constexpr int NS = (MODE == 11) ? 11 : 8;
    constexpr int KI = K / NS;
    float* skb = p.skacc + (size_t)SkOff<MODE>::v * 16384;
    unsigned* tick = p.sktick + SkOff<MODE>::v;
    unsigned* tkw = (unsigned*)smraw;
    const size_t arow = (size_t)128 * 128;
    constexpr int NH = (MODE == 5) ? 2 : 1;
    for (int it = blockIdx.x; it < NT * NS * NH; it += gridDim.x) {
      const int nt = it % NT, ks = (it / NT) % NS, half = it / (NT * NS);
      int tid2 = threadIdx.x;
      asm volatile("" : "+v"(tid2));
      f32x4 acc[4][4];
      ZERO_ACC(acc);
      const bf16_t* Ah = (MODE == 5 && half) ? p.yb : Aop;
      const bf16_t* Bh = (MODE == 5 && half) ? p.Wt_b : Bop;
      gemm_acc(acc, Ah + arow * K + ks * KI, K, Bh + (size_t)nt * 128 * K + ks * KI, K, KI, sm);
      float* dst = skb + (size_t)nt * 16384 + tid2;
      {
        float* dsth = dst + (size_t)half * 8 * 16384;
#pragma unroll
        for (int ci = 0; ci < 4; ++ci)
#pragma unroll
          for (int ri = 0; ri < 4; ++ri) {
#pragma unroll
            for (int j = 0; j < 4; ++j) atomicAdd(dsth + ((ci * 4 + ri) * 4 + j) * 256, acc[ci][ri][j]);
            asm volatile("" ::: "memory");
          }
      }
      asm volatile("s_waitcnt vmcnt(0)" ::: "memory");
      __syncthreads();
      if (tid == 0) tkw[0] = atomicAdd(tick + nt, 1u);
      __syncthreads();
      const unsigned ticket = tkw[0];
      __syncthreads();
      if (ticket == (unsigned)(NS * NH - 1)) {
        if (MODE == 5) {
          const int row0 = 128 * 128 + wr * 64 + fr;
          const int colb = nt * 128 + wc * 64 + fq * 4;
          const float* src2 = skb + (size_t)(8 + nt) * 16384 + tid2;
#pragma unroll
          for (int ci = 0; ci < 4; ++ci)
#pragma unroll
            for (int ri = 0; ri < 4; ++ri) {
              const size_t off = (size_t)(row0 + ri * 16) * 1024 + colb + ci * 16;
              float ga[4], gb[4], o[4];
              unpack4(*reinterpret_cast<const uint2*>(p.P_ga + off), ga);
              unpack4(*reinterpret_cast<const uint2*>(p.P_gb + off), gb);
#pragma unroll
              for (int j = 0; j < 4; ++j) {
                const float ya = __hip_atomic_load(dst + ((ci * 4 + ri) * 4 + j) * 256, __ATOMIC_RELAXED, __HIP_MEMORY_SCOPE_AGENT);
                const float yb = __hip_atomic_load(src2 + ((ci * 4 + ri) * 4 + j) * 256, __ATOMIC_RELAXED, __HIP_MEMORY_SCOPE_AGENT);
                o[j] = sigmoidf_(ga[j]) * ya + sigmoidf_(gb[j]) * yb;
              }
              *reinterpret_cast<uint2*>(p.merged + off) = pack4(o[0], o[1], o[2], o[3]);
              asm volatile("" ::: "memory");
            }
        } else {
#pragma unroll
          for (int ci = 0; ci < 4; ++ci)
#pragma unroll
            for (int ri = 0; ri < 4; ++ri) {
#pragma unroll
              for (int j = 0; j < 4; ++j)
                acc[ci][ri][j] = __hip_atomic_load(dst + ((ci * 4 + ri) * 4 + j) * 256, __ATOMIC_RELAXED, __HIP_MEMORY_SCOPE_AGENT);
              asm volatile("" ::: "memory");
            }
          gemm_epi<MODE>(p, acc, 128, nt);
        }
      }
    }
  }
}

__device__ __forceinline__ void attn_prompt(const Params& p, int item, unsigned char* smraw) {
  const int tid = threadIdx.x, lane = tid & 63, w = tid >> 6;
  const int fr = lane & 15, fq = lane >> 4;
  const int h = item & 3, rt = (item >> 2) & 31, b = item >> 7;
  bf16_t* KV = (bf16_t*)smraw;
  bf16_t* Ps = KV + 64 * 264 + w * 16 * 264;
  const size_t rowbase = (size_t)b * 2048 + rt * 64 + 16 * w;
  bf16x8 qf[8];
#pragma unroll
  for (int ks = 0; ks < 8; ++ks) qf[ks] = ldfrag(p.q + (rowbase + fr) * 1024 + h * 256 + ks * 32 + fq * 8);
  f32x4 sacc[16];
#pragma unroll
  for (int t = 0; t < 16; ++t) sacc[t] = f32x4{0, 0, 0, 0};
#pragma unroll
  for (int kb = 0; kb < 4; ++kb) {
    __syncthreads();
#pragma unroll
    for (int i = 0; i < 8; ++i) {
      const int id = tid + 256 * i, key = id >> 5, c = id & 31;
      *reinterpret_cast<uint4*>(KV + key * 264 + c * 8) =
          *reinterpret_cast<const uint4*>(p.mkb + ((size_t)b * 256 + kb * 64 + key) * 1024 + h * 256 + c * 8);
    }
    __syncthreads();
#pragma unroll
    for (int ct = 0; ct < 4; ++ct)
#pragma unroll
      for (int ks = 0; ks < 8; ++ks)
        sacc[kb * 4 + ct] = mfma16(ldfrag(KV + (ct * 16 + fr) * 264 + ks * 32 + fq * 8), qf[ks], sacc[kb * 4 + ct]);
  }
  float m = -3.0e38f;
#pragma unroll
  for (int t = 0; t < 16; ++t)
#pragma unroll
    for (int j = 0; j < 4; ++j) m = fmaxf(m, sacc[t][j]);
  m = fmaxf(m, __shfl_xor(m, 16)); m = fmaxf(m, __shfl_xor(m, 32));
  float sum = 0.f;
#pragma unroll
  for (int t = 0; t < 16; ++t)
#pragma unroll
    for (int j = 0; j < 4; ++j) { const float e = __expf(sacc[t][j] - m); sacc[t][j] = e; sum += e; }
  sum += __shfl_xor(sum, 16); sum += __shfl_xor(sum, 32);
  const float inv = 1.f / sum;
#pragma unroll
  for (int t = 0; t < 16; ++t)
    *reinterpret_cast<uint2*>(Ps + fr * 264 + t * 16 + fq * 4) = pack4(sacc[t][0] * inv, sacc[t][1] * inv, sacc[t][2] * inv, sacc[t][3] * inv);
  bf16x8 pf[8];
#pragma unroll
  for (int db = 0; db < 4; ++db) {
    __syncthreads();
#pragma unroll
    for (int i = 0; i < 8; ++i) {
      const int id = tid + 256 * i, dr = id >> 5, c = id & 31;
      *reinterpret_cast<uint4*>(KV + dr * 264 + c * 8) =
          *reinterpret_cast<const uint4*>(p.mvT + ((size_t)(b * 4 + h) * 256 + db * 64 + dr) * 256 + c * 8);
    }
    __syncthreads();
    if (db == 0) {
#pragma unroll
      for (int ks = 0; ks < 8; ++ks) pf[ks] = ldfrag(Ps + fr * 264 + ks * 32 + fq * 8);
    }
    f32x4 oacc[4];
#pragma unroll
    for (int mt = 0; mt < 4; ++mt) {
      oacc[mt] = f32x4{0, 0, 0, 0};
#pragma unroll
      for (int ks = 0; ks < 8; ++ks) oacc[mt] = mfma16(ldfrag(KV + (mt * 16 + fr) * 264 + ks * 32 + fq * 8), pf[ks], oacc[mt]);
      *reinterpret_cast<uint2*>(p.ao + (rowbase + fr) * 1024 + h * 256 + db * 64 + mt * 16 + fq * 4) =
          pack4(oacc[mt][0], oacc[mt][1], oacc[mt][2], oacc[mt][3]);
    }
  }
  __syncthreads();
}

__device__ __forceinline__ void attn_sample(const Params& p, int item, unsigned char* smraw) {
  const int tid = threadIdx.x, lane = tid & 63, w = tid >> 6;
  const int b = item >> 2, h = item & 3;
  const size_t row = NPR + b;
  float* sc = (float*)smraw;
  float* red = sc + 256;
  float q4[4];
  unpack4(*reinterpret_cast<const uint2*>(p.q + row * 1024 + h * 256 + lane * 4), q4);
  const float* Kc = p.cache_k + ((size_t)b * 256 * 4 + h) * 256 + lane * 4;
#pragma unroll 16
  for (int i = 0; i < 64; ++i) {
    const int m = w * 64 + i;
    const float4 kv = ldnt4(Kc + (size_t)m * 1024);
    float d = kv.x * q4[0] + kv.y * q4[1] + kv.z * q4[2] + kv.w * q4[3];
    d = wave_sum(d);
    if (lane == 0) sc[m] = d;
  }
  __syncthreads();
  const float s = sc[tid];
  float mx = s;
  for (int o = 32; o > 0; o >>= 1) mx = fmaxf(mx, __shfl_xor(mx, o));
  if (lane == 0) red[w] = mx;
  __syncthreads();
  mx = fmaxf(fmaxf(red[0], red[1]), fmaxf(red[2], red[3]));
  const float e = __expf(s - mx);
  const float sm_ = wave_sum(e);
  if (lane == 0) red[4 + w] = sm_;
  __syncthreads();
  const float tot = (red[4] + red[5]) + (red[6] + red[7]);
  sc[tid] = e / tot;
  __syncthreads();
  {
    float* part = red + 8;
    const int dq = lane * 4, kg = w;
    const float* Vc = p.cache_v + (((size_t)b * 256 + kg * 64) * 4 + h) * 256 + dq;
    float o0 = 0.f, o1 = 0.f, o2 = 0.f, o3 = 0.f;
#pragma unroll 16
    for (int m = 0; m < 64; ++m) {
      const float4 v = ldnt4(Vc + (size_t)m * 1024);
      const float pm = sc[kg * 64 + m];
      o0 += pm * v.x; o1 += pm * v.y; o2 += pm * v.z; o3 += pm * v.w;
    }
    *reinterpret_cast<float4*>(part + kg * 256 + dq) = make_float4(o0, o1, o2, o3);
    __syncthreads();
    p.ao[row * 1024 + h * 256 + tid] = f2bf((part[tid] + part[256 + tid]) + (part[512 + tid] + part[768 + tid]));
  }
  __syncthreads();
}

__device__ __forceinline__ void phase8(const Params& p, unsigned char* smraw) {
  const int G = gridDim.x;
  const bool sample_first = (blockIdx.x & 256) != 0;
  if (sample_first) for (int it = first_item(1024); it < 1536; it += G) attn_sample(p, it - 1024, smraw);
  for (int it = first_item(0); it < 1024; it += G) attn_prompt(p, it, smraw);
  if (!sample_first) for (int it = first_item(1024); it < 1536; it += G) attn_sample(p, it - 1024, smraw);
}

__device__ __forceinline__ void phase12(const Params& p) {
  const int tid = threadIdx.x, lane = tid & 63, wid = tid >> 6;
  for (int r = blockIdx.x * 4 + wid; r < NTOK; r += gridDim.x * 4) {
    const float rs = row_rs(p.ss3, r);
    float* o = p.out + (size_t)r * 1024;
#pragma unroll
    for (int i = 0; i < 4; ++i) {
      float4 v = *reinterpret_cast<const float4*>(o + i * 256 + lane * 4);
      const float4 g = *reinterpret_cast<const float4*>(p.norm_final_g + i * 256 + lane * 4);
      v.x *= rs * g.x; v.y *= rs * g.y; v.z *= rs * g.z; v.w *= rs * g.w;
      *reinterpret_cast<float4*>(o + i * 256 + lane * 4) = v;
    }
  }
}


#define XB_TMO      128
#define XB_XCNT(j)  (256  + 64 * (j))
#define XB_XSUB(j)  (1280 + 64 * (j))
#define XB_XGEN(j)  (2304 + 64 * (j))
#define XB_TOP      3328
#define XB_TOPGEN   3392
#define XCD_BAR_WORDS 3456
#define XB_SPIN_CAP (1u << 22)
#define LAS __attribute__((address_space(3)))
__device__ __forceinline__ unsigned xb_ld(unsigned* p) { return __hip_atomic_load(p, __ATOMIC_RELAXED, __HIP_MEMORY_SCOPE_AGENT); }
__device__ __forceinline__ unsigned xb_add(unsigned* p, unsigned v) { return __hip_atomic_fetch_add(p, v, __ATOMIC_RELAXED, __HIP_MEMORY_SCOPE_AGENT); }
__device__ __forceinline__ unsigned xb_xcc_id() { return (unsigned)__builtin_amdgcn_s_getreg((3 << 11) | 20) & 0xFu; }
#define XB_SPIN(cond, bar) do { unsigned _sp = 0; while (cond) { __builtin_amdgcn_s_sleep(1); \
    if ((++_sp & 255u) == 0u) { if (xb_ld(&(bar)[XB_TMO])) break; if (_sp > XB_SPIN_CAP) { atomicAdd(&(bar)[XB_TMO], 1u); break; } } } } while (0)
struct XcdBarrier { unsigned* bar; unsigned x; volatile LAS unsigned* st; };
__device__ __forceinline__ XcdBarrier xcd_barrier_post(unsigned* bar, volatile LAS unsigned* st) {
  XcdBarrier b; b.bar = bar; b.x = xb_xcc_id(); b.st = st;
  if (threadIdx.x == 0) (void)xb_add(&bar[XB_XCNT(b.x)], 1u);
  return b;
}
__device__ __forceinline__ void xcd_barrier_complete(unsigned* bar, unsigned x, unsigned& nloc, unsigned& nx) {
  const unsigned G = gridDim.x * gridDim.y * gridDim.z;
  unsigned sum, cnt, mine, sp = 0u;
  for (;;) {
    sum = 0u; cnt = 0u; mine = 0u;
#pragma unroll
    for (unsigned j = 0; j < 16; ++j) { const unsigned c = xb_ld(&bar[XB_XCNT(j)]); sum += c; cnt += (c > 0u) ? 1u : 0u; mine = (j == x) ? c : mine; }
    if (sum == G) break;
    __builtin_amdgcn_s_sleep(1);
    if ((++sp & 255u) == 0u) { if (xb_ld(&bar[XB_TMO])) break; if (sp > XB_SPIN_CAP) { atomicAdd(&bar[XB_TMO], 1u); break; } }
  }
  nloc = mine > 0u ? mine : 1u; nx = cnt > 0u ? cnt : 1u;
}
__device__ __forceinline__ void xcd_barrier(const XcdBarrier& b) {
  asm volatile("s_waitcnt vmcnt(0)" ::: "memory");
  __syncthreads();
  if (threadIdx.x == 0) {
    unsigned* bar = b.bar;
    __builtin_amdgcn_s_waitcnt(0);
    unsigned nloc = b.st[0], nx = b.st[1];
    if (nloc == 0u) { xcd_barrier_complete(bar, b.x, nloc, nx); b.st[0] = nloc; b.st[1] = nx; }
    const unsigned old = xb_add(&bar[XB_XSUB(b.x)], 1u);
    const unsigned gen = old / nloc;
    if (old + 1u == (gen + 1u) * nloc) {
      __builtin_amdgcn_fence(__ATOMIC_RELEASE, "agent");
      asm volatile("s_waitcnt vmcnt(0)" ::: "memory");
      const unsigned og = xb_add(&bar[XB_TOP], 1u);
      const unsigned tg = og / nx;
      if (og + 1u == (tg + 1u) * nx) xb_add(&bar[XB_TOPGEN], 1u);
      else XB_SPIN(xb_ld(&bar[XB_TOPGEN]) == tg, bar);
      __builtin_amdgcn_fence(__ATOMIC_ACQUIRE, "agent");
      xb_add(&bar[XB_XGEN(b.x)], 1u);
      asm volatile("s_waitcnt vmcnt(0)" ::: "memory");
    } else {
      XB_SPIN(xb_ld(&bar[XB_XGEN(b.x)]) == gen, bar);
      __builtin_amdgcn_fence(__ATOMIC_ACQUIRE, "agent");
      asm volatile("s_waitcnt vmcnt(0)" ::: "memory");
    }
  }
  __syncthreads();
}

__global__ void __launch_bounds__(256, 2) mega(Params p, int ph_lo, int ph_hi) {
  __shared__ __attribute__((aligned(16))) unsigned char smem[SMEM_BYTES];
  __shared__ uint4 xb_words;
  cg::grid_group grid = cg::this_grid();
  if (ph_lo > 1000) grid.sync();
  if (threadIdx.x == 0) xb_words = make_uint4(0u, 0u, 0u, 0u);
  __syncthreads();
  XcdBarrier xb = xcd_barrier_post(p.bar, (volatile LAS unsigned*)&xb_words);
#ifdef ONLY_PHASE
#define RUNPH(PH, CALL) if (PH == ONLY_PHASE && ph_lo <= PH && PH < ph_hi) { if (PH > ph_lo) xcd_barrier(xb); CALL; }
#else
#define RUNPH(PH, CALL) if (ph_lo <= PH && PH < ph_hi) { if (PH > ph_lo) xcd_barrier(xb); CALL; }
#endif
  RUNPH(0, phase0(p, smem))
  RUNPH(1, phase1(p, smem))
  RUNPH(2, phase2(p, smem))
  RUNPH(3, phase3(p, smem))
  RUNPH(4, phase4(p))
  RUNPH(5, gemm_phase<5>(p, smem))
  RUNPH(6, gemm_phase<6>(p, smem))
  RUNPH(7, gemm_phase<7>(p, smem))
  RUNPH(8, phase8(p, smem))
  RUNPH(9, gemm_phase<9>(p, smem))
  RUNPH(10, gemm_phase<10>(p, smem))
  RUNPH(11, gemm_phase<11>(p, smem))
  RUNPH(12, phase12(p))
}

static inline size_t al256(size_t x) { return (x + 255) & ~(size_t)255; }

extern "C" void kernel_launch(void* const* d_in, const int* in_sizes, int n_in, void* d_out, int out_size, void* d_ws,
                              size_t ws_size, hipStream_t stream) {
  static int grid_blocks = 0;
  if (!grid_blocks) {
    int dev = 0, cus = 0, per_cu = 0;
    hipGetDevice(&dev);
    hipDeviceGetAttribute(&cus, hipDeviceAttributeMultiprocessorCount, dev);
    hipOccupancyMaxActiveBlocksPerMultiprocessor(&per_cu, mega, 256, 0);
    if (per_cu > 2) per_cu = 2;
    if (per_cu < 1) per_cu = 1;
    grid_blocks = cus * per_cu;
  }
  Params p{};
  const float* const* in = (const float* const*)d_in;
  p.x_prompt = in[0]; p.x_sample = in[1]; p.state_ret = in[2]; p.state_gdn = in[3]; p.state_conv = in[4];
  p.cache_k = in[5]; p.cache_v = in[6]; p.mem_prompt = in[7];
  p.norm_mix_g = in[8]; p.w_in = in[9]; p.ret_gn_g = in[10]; p.w_a = in[11]; p.conv_w = in[12]; p.a_log = in[13];
  p.dt_bias = in[14]; p.gdn_norm_g = in[15]; p.w_b = in[16]; p.w_out = in[17]; p.norm_x_g = in[18]; p.mem_norm_g = in[19];
  p.w_xq = in[20]; p.w_xk = in[21]; p.w_xv = in[22]; p.w_xo = in[23]; p.norm_ffn_g = in[24]; p.w_gate = in[25];
  p.w_up = in[26]; p.w_down = in[27]; p.norm_final_g = in[28];
  p.out = (float*)d_out;

  unsigned char* ws = (unsigned char*)d_ws;
  size_t off = 0;
  auto take = [&](size_t bytes) { unsigned char* r = ws + off; off = al256(off + bytes); return r; };
  const size_t ACT = (size_t)NTOK * 1024 * 2;
  p.Wt_in = (bf16_t*)take((size_t)9344 * 1024 * 2);
  p.Wt_a = (bf16_t*)take((size_t)1024 * 1024 * 2);
  p.Wt_b = (bf16_t*)take((size_t)1024 * 1024 * 2);
  p.Wt_out = (bf16_t*)take((size_t)1024 * 1024 * 2);
  p.Wt_xq = (bf16_t*)take((size_t)1024 * 1024 * 2);
  p.Wt_kv = (bf16_t*)take((size_t)2048 * 1024 * 2);
  p.Wt_xo = (bf16_t*)take((size_t)1024 * 1024 * 2);
  p.Wt_gu = (bf16_t*)take((size_t)5632 * 1024 * 2);
  p.Wt_down = (bf16_t*)take((size_t)1024 * 2816 * 2);
  {
    unsigned char* rh = take((size_t)1024 * 40960);
    p.h = (bf16_t*)rh;
    p.r_QD = (bf16_t*)rh;
    p.r_KDT = (bf16_t*)(rh + (size_t)1024 * 16384);
    p.r_SC = (bf16_t*)(rh + (size_t)1024 * 32768);
  }
  p.P_rqk = (bf16_t*)take(ACT);
  p.P_rv = (bf16_t*)take(ACT);
  p.P_rg = (bf16_t*)take(ACT);
  p.P_qkv = (bf16_t*)take(ACT * 3);
  p.P_z = (bf16_t*)take(ACT);
  p.P_ga = (bf16_t*)take(ACT);
  p.P_gb = (bf16_t*)take(ACT);
  {
    unsigned char* rg = take((size_t)2048 * 73728);
    p.g_W = (bf16_t*)rg;
    p.g_QH = (bf16_t*)(rg + (size_t)2048 * 16384);
    p.g_KT = (bf16_t*)(rg + (size_t)2048 * 32768);
    p.g_U = (bf16_t*)(rg + (size_t)2048 * 49152);
    p.g_QK = (bf16_t*)(rg + (size_t)2048 * 65536);
    p.ya = (bf16_t*)rg;
    p.yb = (bf16_t*)(rg + ACT);
  }
  p.g_GS = (float*)take((size_t)2048 * 128 * 4);
  p.mn = (bf16_t*)take((size_t)2048 * 1024 * 2);
  p.ropec = (float*)take((size_t)2049 * 64 * 4);
  p.ropes = (float*)take((size_t)2049 * 64 * 4);
  p.beta = (float*)take((size_t)NTOK * 8 * 4);
  p.gl = (float*)take((size_t)NTOK * 8 * 4);
  p.mkb = (bf16_t*)take((size_t)2048 * 1024 * 2);
  p.mvT = (bf16_t*)take((size_t)2048 * 1024 * 2);
  p.ss1 = (float*)take((size_t)NTOK * 16 * 4);
  p.ss2 = (float*)take((size_t)NTOK * 16 * 4);
  p.ss3 = (float*)take((size_t)NTOK * 16 * 4);
  p.bar = (unsigned*)take((size_t)XCD_BAR_WORDS * 4);
  p.skacc = (float*)take((size_t)92 * 16384 * 4);
  p.sktick = (unsigned*)take((size_t)128 * 4);
  p.o_r = p.P_qkv;
  p.o_g = (bf16_t*)((unsigned char*)p.P_qkv + ACT);
  p.merged = p.P_rqk;
  p.x1b = p.P_rv;
  p.q = p.P_rg;
  p.ao = p.P_z;
  p.x2b = p.P_ga;
  p.ff = p.P_qkv;
  if (off > ws_size) {
    fprintf(stderr, "kernel_launch: workspace too small: need %zu have %zu\n", off, ws_size);
    return;
  }
  int t0 = 0;
  auto job = [&](int i, const float* s0, const float* s1, const float* gf, bf16_t* dst, int ld, int K, int Nd, int mode, float scale) {
    p.jobs[i].src0 = s0; p.jobs[i].src1 = s1; p.jobs[i].gfold = gf; p.jobs[i].dst = dst; p.jobs[i].ld_src = ld;
    p.jobs[i].K = K; p.jobs[i].Nd = Nd; p.jobs[i].mode = mode; p.jobs[i].scale = scale; p.jobs[i].tile0 = t0;
    t0 += (Nd / 64) * (K / 256);
  };
  job(0, p.w_in, nullptr, p.norm_mix_g, p.Wt_in, 9232, 1024, 9344, 1, 1.f);
  job(1, p.w_a, nullptr, nullptr, p.Wt_a, 1024, 1024, 1024, 0, 1.f);
  job(2, p.w_b, nullptr, nullptr, p.Wt_b, 1024, 1024, 1024, 0, 1.f);
  job(3, p.w_out, nullptr, nullptr, p.Wt_out, 1024, 1024, 1024, 0, 1.f);
  job(4, p.w_xq, nullptr, p.norm_x_g, p.Wt_xq, 1024, 1024, 1024, 0, 0.0625f);
  job(5, p.w_xk, p.w_xv, p.mem_norm_g, p.Wt_kv, 1024, 1024, 2048, 3, 1.f);
  job(6, p.w_xo, nullptr, nullptr, p.Wt_xo, 1024, 1024, 1024, 0, 1.f);
  job(7, p.w_gate, p.w_up, p.norm_ffn_g, p.Wt_gu, 2816, 1024, 5632, 2, 1.f);
  job(8, p.w_down, nullptr, nullptr, p.Wt_down, 1024, 2816, 1024, 0, 1.f);
  p.n_wtiles = t0;

#ifdef MULTI_LAUNCH
  for (int ph = 0; ph < NPHASE; ++ph) {
    hipLaunchKernelGGL(mega, dim3(grid_blocks), dim3(256), 0, stream, p, ph, ph + 1);
  }
#else
  hipMemsetAsync(p.bar, 0, (size_t)XCD_BAR_WORDS * 4, stream);
  int lo = 0, hi = NPHASE;
  void* args[] = {&p, &lo, &hi};
  hipError_t e = hipLaunchCooperativeKernel((void*)mega, dim3(grid_blocks), dim3(256), args, 0, stream);
  if (e != hipSuccess) fprintf(stderr, "cooperative launch failed: %s (grid %d)\n", hipGetErrorString(e), grid_blocks);
#endif
}
```
